# Optimizing an MI355X kernel written in HIP

```python
import math
import jax, jax.numpy as jnp
from jax import lax
import numpy as np

D_MODEL = 4096
BATCH = 8
SEQ = 2048
DEPTH = 1

H_A = 16
QK_NOPE = 128
QK_ROPE = 64
QK_DIM_A = QK_NOPE + QK_ROPE
V_DIM_A = 128
Q_LORA = 1024
KV_LORA = 512
ROPE_THETA = 10000.0
H_B = 16
HEAD_DIM_B = 128
IDX_HEADS = 32
IDX_DIM = 64
TOPK_MAX = 256
N_BUCKETS = 32
MAX_DISTANCE = 128
Q_BLOCK = 128
EPS = 1e-6

WIDTH_A = H_A * V_DIM_A
WIDTH_B = H_B * HEAD_DIM_B

COL_SIZES = [
    Q_LORA,
    KV_LORA,
    QK_ROPE,
    H_B * HEAD_DIM_B,
    HEAD_DIM_B,
    HEAD_DIM_B,
    IDX_HEADS * IDX_DIM,
    IDX_DIM,
    IDX_HEADS,
    WIDTH_A,
    WIDTH_B,
    D_MODEL,
    D_MODEL,
]
IN_COLS = int(sum(COL_SIZES))
SPLIT_POINTS = [int(v) for v in np.cumsum(COL_SIZES)[:-1]]

kernel_name = "hybrid_mla_dsa_gated_merge"


def rmsnorm(x, g):
    xf = x.astype(jnp.float32)
    y = xf * lax.rsqrt(jnp.mean(xf * xf, axis=-1, keepdims=True) + EPS)
    return (y * g.astype(jnp.float32)).astype(x.dtype)


def apply_rope(x, pos):
    half = x.shape[-1] // 2
    inv = ROPE_THETA ** (-jnp.arange(half, dtype=jnp.float32) / half)
    ang = pos.astype(jnp.float32)[:, :, None, None] * inv
    cos, sin = jnp.cos(ang), jnp.sin(ang)
    x1 = x[..., :half].astype(jnp.float32)
    x2 = x[..., half:].astype(jnp.float32)
    return jnp.concatenate([x1 * cos - x2 * sin, x1 * sin + x2 * cos], axis=-1).astype(x.dtype)


def t5_bucket(dist):
    max_exact = N_BUCKETS // 2
    n = jnp.maximum(dist, 0)
    nf = jnp.maximum(n, 1).astype(jnp.float32)
    large = max_exact + (jnp.log(nf / max_exact) / math.log(MAX_DISTANCE / max_exact)
                         * (N_BUCKETS - max_exact)).astype(jnp.int32)
    large = jnp.minimum(large, N_BUCKETS - 1)
    return jnp.where(n < max_exact, n, large)


def to_blocks(a):
    b, l = a.shape[0], a.shape[1]
    a = a.reshape((b, l // Q_BLOCK, Q_BLOCK) + a.shape[2:])
    return jnp.moveaxis(a, 1, 0)


def from_blocks(a):
    a = jnp.moveaxis(a, 0, 1)
    return a.reshape((a.shape[0], a.shape[1] * a.shape[2]) + a.shape[3:])


def causal_dense_attention(q, k, v, pos, scale):
    def one(args):
        qi, pi = args
        s = jnp.einsum('bqhd,bshd->bhqs', qi, k, preferred_element_type=jnp.float32) * scale
        mask = pi[:, None, :, None] >= pos[:, None, None, :]
        s = jnp.where(mask, s, -jnp.inf)
        p = jax.nn.softmax(s, axis=-1).astype(v.dtype)
        return jnp.einsum('bhqs,bshd->bqhd', p, v)
    out = lax.map(one, (to_blocks(q), to_blocks(pos)))
    return from_blocks(out)


def indexed_sparse_attention(q, k, v, q_idx, k_idx, w_idx, pos, t5_bias, scale):
    n_keys = k.shape[1]
    topk = min(TOPK_MAX, n_keys // 4)
    gather = jax.vmap(lambda table, idx: table[idx])

    def one(args):
        qi, qxi, wi, pi = args
        logits = jnp.einsum('bqhd,bsd->bqsh', qxi, k_idx, preferred_element_type=jnp.float32)
        score = jnp.einsum('bqsh,bqh->bqs', jax.nn.relu(logits), wi.astype(jnp.float32))
        admissible = pi[:, :, None] >= pos[:, None, :]
        score = jnp.where(admissible, score, -jnp.inf)
        _, sel = lax.top_k(score, topk)
        kg = gather(k, sel)
        vg = gather(v, sel)
        dist = pi[:, :, None] - gather(pos, sel)
        bias = t5_bias[t5_bucket(dist)].astype(jnp.float32)
        s = jnp.einsum('bqhd,bqkd->bqhk', qi, kg, preferred_element_type=jnp.float32) * scale
        s = s + jnp.swapaxes(bias, -1, -2)
        s = jnp.where((dist >= 0)[:, :, None, :], s, -jnp.inf)
        p = jax.nn.softmax(s, axis=-1).astype(vg.dtype)
        return jnp.einsum('bqhk,bqkd->bqhd', p, vg)

    out = lax.map(one, (to_blocks(q), to_blocks(q_idx), to_blocks(w_idx), to_blocks(pos)))
    return from_blocks(out)


def setup_inputs(seed: int = 0) -> dict:
    key = jax.random.key(seed)
    ks = jax.random.split(key, 20)
    f32 = jnp.float32
    nrm = lambda k, shape, fan: jax.random.normal(k, shape, f32) * (fan ** -0.5)
    gain = lambda k, n: 1.0 + 0.05 * jax.random.normal(k, (n,), f32)
    x = jax.random.normal(ks[0], (BATCH, SEQ, D_MODEL), f32)
    offset = jax.random.randint(ks[1], (BATCH, 1), 0, 1024, dtype=jnp.int32)
    positions = offset + jnp.arange(SEQ, dtype=jnp.int32)[None, :]
    return {
        "x": x,
        "positions": positions,
        "g_pre": gain(ks[2], D_MODEL),
        "w_in": nrm(ks[3], (D_MODEL, IN_COLS), D_MODEL),
        "g_q_lat": gain(ks[4], Q_LORA),
        "g_kv_lat": gain(ks[5], KV_LORA),
        "w_uq": nrm(ks[6], (Q_LORA, H_A * QK_DIM_A), Q_LORA),
        "w_ukv": nrm(ks[7], (KV_LORA, H_A * (QK_NOPE + V_DIM_A)), KV_LORA),
        "g_qn_a": gain(ks[8], QK_DIM_A),
        "g_kn_a": gain(ks[9], QK_DIM_A),
        "g_qn_b": gain(ks[10], HEAD_DIM_B),
        "g_kn_b": gain(ks[11], HEAD_DIM_B),
        "t5_bias": 0.5 * jax.random.normal(ks[12], (N_BUCKETS, H_B), f32),
        "p_a": nrm(ks[13], (WIDTH_A, D_MODEL), WIDTH_A),
        "p_b": nrm(ks[14], (WIDTH_B, D_MODEL), WIDTH_B),
        "w_o": nrm(ks[15], (D_MODEL, D_MODEL), D_MODEL),
    }


def reference(x, positions, g_pre, w_in, g_q_lat, g_kv_lat, w_uq, w_ukv, g_qn_a, g_kn_a,
              g_qn_b, g_kn_b, t5_bias, p_a, p_b, w_o):
    b, l, _ = x.shape
    h = x
    for _layer in range(DEPTH):
        hn = rmsnorm(h, g_pre)
        proj = hn @ w_in
        (cq, ckv, k_rope, q_b, k_b, v_b, q_idx, k_idx, w_idx,
         gate_a, gate_b, merge_a, merge_b) = jnp.split(proj, SPLIT_POINTS, axis=-1)

        q_a = (rmsnorm(cq, g_q_lat) @ w_uq).reshape(b, l, H_A, QK_DIM_A)
        kv = (rmsnorm(ckv, g_kv_lat) @ w_ukv).reshape(b, l, H_A, QK_NOPE + V_DIM_A)
        k_nope, v_a = kv[..., :QK_NOPE], kv[..., QK_NOPE:]
        k_r = jnp.broadcast_to(k_rope[:, :, None, :], (b, l, H_A, QK_ROPE))
        k_a = jnp.concatenate([k_nope, k_r], axis=-1)
        q_a = rmsnorm(q_a, g_qn_a)
        k_a = rmsnorm(k_a, g_kn_a)
        q_a = jnp.concatenate([q_a[..., :QK_NOPE], apply_rope(q_a[..., QK_NOPE:], positions)], -1)
        k_a = jnp.concatenate([k_a[..., :QK_NOPE], apply_rope(k_a[..., QK_NOPE:], positions)], -1)
        o_a = causal_dense_attention(q_a, k_a, v_a, positions, QK_DIM_A ** -0.5)
        o_a = o_a.reshape(b, l, WIDTH_A) * jax.nn.silu(gate_a)

        q_bh = rmsnorm(q_b.reshape(b, l, H_B, HEAD_DIM_B), g_qn_b)
        k_bh = rmsnorm(k_b, g_kn_b)
        q_ix = q_idx.reshape(b, l, IDX_HEADS, IDX_DIM)
        w_ix = w_idx * (IDX_HEADS ** -0.5)
        o_b = indexed_sparse_attention(q_bh, k_bh, v_b, q_ix, k_idx, w_ix, positions,
                                       t5_bias, HEAD_DIM_B ** -0.5)
        o_b = o_b.reshape(b, l, WIDTH_B) * jax.nn.silu(gate_b)

        merged = jax.nn.sigmoid(merge_a) * (o_a @ p_a) + jax.nn.sigmoid(merge_b) * (o_b @ p_b)
        h = h + merged @ w_o
    return h
```

```cpp
#include <hip/hip_runtime.h>
#include <hip/hip_cooperative_groups.h>
#include <cstdio>
#include <cstdint>
namespace cg = cooperative_groups;

#ifndef MK_MULTI
#define MK_MULTI 0
#endif

#ifndef MK_DUP
#define MK_DUP -1
#endif
#define LAS __attribute__((address_space(3)))
#define DI __device__ __forceinline__
typedef unsigned short bf16_t;
typedef short bf16x8 __attribute__((ext_vector_type(8)));
typedef short s16x4 __attribute__((ext_vector_type(4)));
typedef float f32x4 __attribute__((ext_vector_type(4)));
typedef float f32x16 __attribute__((ext_vector_type(16)));
typedef unsigned u32x4 __attribute__((ext_vector_type(4)));
typedef unsigned u32x2 __attribute__((ext_vector_type(2)));
typedef int i32x4 __attribute__((ext_vector_type(4)));
typedef __bf16 bf16v2 __attribute__((ext_vector_type(2)));
typedef float f32v2 __attribute__((ext_vector_type(2)));

constexpr int DM = 4096, NBATCH = 8, L = 2048, M = NBATCH * L;
constexpr int LDP = 18432, NCOLS = 18336;
constexpr int C_CQ = 0, C_CKV = 1024, C_KROPE = 1536, C_QB = 1600, C_KB = 3648, C_VB = 3776, C_QIDX = 3904, C_KIDX = 5952, C_WIDX = 6016,
              C_GA = 6048, C_GB = 8096, C_MA = 10144, C_MB = 14240;
constexpr float EPS = 1e-6f;
constexpr float LOG2E = 1.4426950408889634f;
constexpr float QSA = 0.07216878364870322f * LOG2E;
constexpr float QSB = 0.08838834764831845f * LOG2E;
constexpr int NTHREADS = 512, NWAVES = 8;
constexpr int LDS_BYTES = 160256;

constexpr size_t WS_WIN_T = 0;
constexpr size_t WS_HN    = 150994944;
constexpr size_t WS_PROJ  = 285212672;
constexpr size_t WS_QB    = 889192448;
constexpr size_t WS_WUQ_T = 956301312;
constexpr size_t WS_WUKV_T= 962592768;
constexpr size_t WS_PCAT_T= 966787072;
constexpr size_t WS_WO_T  = 1000341504;
constexpr size_t WS_KB    = 1033895936;
constexpr size_t WS_VBT   = 1038090240;
constexpr size_t WS_KIDX  = 1042284544;
constexpr size_t WS_BAR   = 1044381696;
constexpr size_t WS_END   = WS_BAR + 16384;
constexpr size_t DO_QA = 0, DO_KA = 100663296, DO_VAT = 201326592;

DI float bf2f(unsigned v) { return __uint_as_float(v << 16); }
DI unsigned pk2(float lo, float hi) { f32v2 v = {lo, hi}; bf16v2 b = __builtin_convertvector(v, bf16v2); return __builtin_bit_cast(unsigned, b); }
DI float lo16(unsigned w) { return __uint_as_float(w << 16); }
DI float hi16(unsigned w) { return __uint_as_float(w & 0xffff0000u); }
template <int CTRL> DI float dpp_mov(float v) { return __builtin_bit_cast(float, __builtin_amdgcn_update_dpp(0, __builtin_bit_cast(int, v), CTRL, 0xF, 0xF, true)); }
DI float row_sum(float v) {
    v += dpp_mov<0xB1>(v); v += dpp_mov<0x4E>(v); v += dpp_mov<0x141>(v); v += dpp_mov<0x140>(v);
    return v;
}
DI float half_sum(float v) { v = row_sum(v); v += __shfl_xor(v, 16); return v; }
DI float wave_sum(float v) { v = half_sum(v); v += __shfl_xor(v, 32); return v; }
DI float sumsq8(u32x4 a) {
    float s = 0.f;
#pragma unroll
    for (int i = 0; i < 4; ++i) { const float x = lo16(a[i]), y = hi16(a[i]); s += x * x + y * y; }
    return s;
}

namespace pg8 {
constexpr int BM = 256, BK = 64, HALF = 128, HTB = HALF * BK * 2, STAGE_BYTES = 8 * HTB, NXCD = 8, WGM = 8;
__host__ __device__ __forceinline__ int lds_byte(int r, int c) { const int st = (r >> 4) * 2 + (c >> 5), rr = r & 15, cc = c & 31, ob = rr * 64 + cc * 2; return st * 1024 + (ob ^ (((ob >> 9) & 1) << 5)); }
__host__ __device__ __forceinline__ void stage_rc(int b, int& R, int& C) { const int st = b / 1024, sb = b % 1024, swz = sb ^ (((sb >> 9) & 1) << 5); R = (st >> 1) * 16 + swz / 64; C = (st & 1) * 32 + (swz % 64) / 2; }
__host__ __device__ __forceinline__ int perm32(int rho) { const int n = rho >> 4, i = rho & 15; return 8 * (i >> 2) + 4 * n + (i & 3); }
struct Unit { int pm, pn; };
struct Gemm { const bf16_t* A; const bf16_t* Bt; int M, N, K, lda, ldb; };
struct StaticOrder {
    int nM, nN, nwg, G, c;
    __device__ void init(int M_, int N_, int G_, int c_) { nM = M_ / BM; nN = N_ / BM; nwg = nM * nN; G = G_; c = c_; }
    __device__ bool next(int i, Unit& u) const {
        const long Lx = (long)i * G + c; if (Lx >= nwg) return false;
        int wgid = (int)Lx; { const int q = nwg / NXCD, r = nwg % NXCD, xcd = wgid % NXCD, off = wgid / NXCD; wgid = (xcd < r ? xcd * (q + 1) : r * (q + 1) + (xcd - r) * q) + off; }
        const int nig = WGM * nN, gid = wgid / nig, fm = gid * WGM, gsz = (nM - fm) < WGM ? (nM - fm) : WGM;
        u.pm = fm + ((wgid % nig) % gsz); u.pn = (wgid % nig) / gsz; return true;
    }
};
struct EpiBf16 {
    static constexpr bool PERM = true, MID = false;
    bf16_t* O; int ldc;
    DI void mid(f32x4 (&)[2][2][4][2], const Unit&, int, int, int, int) const {}
    DI void operator()(const f32x4 (&acc)[2][2][4][2], const Unit& u, int wr, int wc, int fr, int fq) const {
        const int row0 = u.pm * BM + wr * 64 + fr, col0 = u.pn * BM + wc * 32 + 8 * fq;
#pragma unroll
        for (int ai = 0; ai < 2; ++ai)
#pragma unroll
            for (int m = 0; m < 4; ++m) { bf16_t* rowp = O + (size_t)(row0 + ai * HALF + m * 16) * ldc + col0;
#pragma unroll
                for (int bj = 0; bj < 2; ++bj) { const f32x4 v0 = acc[ai][bj][m][0], v1 = acc[ai][bj][m][1];
                    u32x4 w; w.x = pk2(v0[0], v0[1]); w.y = pk2(v0[2], v0[3]); w.z = pk2(v1[0], v1[1]); w.w = pk2(v1[2], v1[3]);
                    *(u32x4*)(rowp + bj * HALF) = w; } }
    }
};
DI float clampm(float x) { return fminf(fmaxf(x, -30.f), 30.f); }
struct EpiMerge {
    static constexpr bool PERM = true, MID = true;
    bf16_t* O; int ldc; const bf16_t* proj;
    DI void mid(f32x4 (&acc)[2][2][4][2], const Unit& u, int wr, int wc, int fr_in, int fq) const {
        int fr = fr_in; asm volatile("" : "+v"(fr));
        const int row0 = u.pm * BM + wr * 64 + fr, col0 = u.pn * BM + wc * 32 + 8 * fq;
#pragma unroll
        for (int ai = 0; ai < 2; ++ai) {
            u32x4 ga[4][2], gb[4][2];
#pragma unroll
            for (int m = 0; m < 4; ++m) { const bf16_t* pr = proj + (size_t)(row0 + ai * HALF + m * 16) * LDP + col0;
#pragma unroll
                for (int bj = 0; bj < 2; ++bj) { ga[m][bj] = *(const u32x4*)(pr + C_MA + bj * HALF); gb[m][bj] = *(const u32x4*)(pr + C_MB + bj * HALF); } }
#pragma unroll
            for (int m = 0; m < 4; ++m)
#pragma unroll
                for (int bj = 0; bj < 2; ++bj)
#pragma unroll
                    for (int i = 0; i < 4; ++i) {
                        const float ma0 = clampm(lo16(ga[m][bj][i])), ma1 = clampm(hi16(ga[m][bj][i])), mb0 = clampm(lo16(gb[m][bj][i])), mb1 = clampm(hi16(gb[m][bj][i]));
                        const float r0 = (1.f + __expf(-mb0)) * __builtin_amdgcn_rcpf(1.f + __expf(-ma0)), r1 = (1.f + __expf(-mb1)) * __builtin_amdgcn_rcpf(1.f + __expf(-ma1));
                        acc[ai][bj][m][i >> 1][(i & 1) * 2] *= r0; acc[ai][bj][m][i >> 1][(i & 1) * 2 + 1] *= r1; }
            asm volatile("" ::: "memory"); }
    }
    DI void operator()(const f32x4 (&acc)[2][2][4][2], const Unit& u, int wr, int wc, int fr, int fq) const {
        const int row0 = u.pm * BM + wr * 64 + fr, col0 = u.pn * BM + wc * 32 + 8 * fq;
        u32x4 gb[2][4][2];
#pragma unroll
        for (int ai = 0; ai < 2; ++ai)
#pragma unroll
            for (int m = 0; m < 4; ++m) { const bf16_t* pr = proj + (size_t)(row0 + ai * HALF + m * 16) * LDP + col0;
#pragma unroll
                for (int bj = 0; bj < 2; ++bj) gb[ai][m][bj] = *(const u32x4*)(pr + C_MB + bj * HALF); }
#pragma unroll
        for (int ai = 0; ai < 2; ++ai)
#pragma unroll
            for (int m = 0; m < 4; ++m) { bf16_t* rowp = O + (size_t)(row0 + ai * HALF + m * 16) * ldc + col0;
#pragma unroll
                for (int bj = 0; bj < 2; ++bj) { float o[8];
#pragma unroll
                    for (int i = 0; i < 4; ++i) { const float mb0 = clampm(lo16(gb[ai][m][bj][i])), mb1 = clampm(hi16(gb[ai][m][bj][i]));
                        o[2 * i] = acc[ai][bj][m][i >> 1][(i & 1) * 2] * __builtin_amdgcn_rcpf(1.f + __expf(-mb0)); o[2 * i + 1] = acc[ai][bj][m][i >> 1][(i & 1) * 2 + 1] * __builtin_amdgcn_rcpf(1.f + __expf(-mb1)); }
                    u32x4 w; w.x = pk2(o[0], o[1]); w.y = pk2(o[2], o[3]); w.z = pk2(o[4], o[5]); w.w = pk2(o[6], o[7]);
                    *(u32x4*)(rowp + bj * HALF) = w; } }
    }
};
struct EpiResid {
    static constexpr bool PERM = false, MID = false;
    const float* base; float* out; int ldc;
    DI void mid(f32x4 (&)[2][2][4][2], const Unit&, int, int, int, int) const {}
    DI void operator()(const f32x4 (&acc)[2][2][4][2], const Unit& u, int wr, int wc, int fr, int fq) const {
        const int row0 = u.pm * BM + wr * 64 + fr, col0 = u.pn * BM + wc * 32 + 4 * fq;
#pragma unroll
        for (int ai = 0; ai < 2; ++ai) {
            f32x4 bs[4][2][2];
#pragma unroll
            for (int m = 0; m < 4; ++m) { const size_t off = (size_t)(row0 + ai * HALF + m * 16) * ldc + col0;
#pragma unroll
                for (int bj = 0; bj < 2; ++bj)
#pragma unroll
                    for (int n = 0; n < 2; ++n) bs[m][bj][n] = *(const f32x4*)(base + off + bj * HALF + n * 16); }
#pragma unroll
            for (int m = 0; m < 4; ++m) { const size_t off = (size_t)(row0 + ai * HALF + m * 16) * ldc + col0;
#pragma unroll
                for (int bj = 0; bj < 2; ++bj)
#pragma unroll
                    for (int n = 0; n < 2; ++n) *(f32x4*)(out + off + bj * HALF + n * 16) = bs[m][bj][n] + acc[ai][bj][m][n]; }
            asm volatile("" ::: "memory"); }
    }
};

template <class Epi, bool ALIGN_EPI = true, bool SP2 = true>
DI void gemm_phase(LAS unsigned char* lds, const Gemm g, const StaticOrder& S, const Epi& E) {
    const int tid = threadIdx.x, wid = __builtin_amdgcn_readfirstlane(tid >> 6), lane = tid & 63, wr = wid >> 2, wc = wid & 3, fr = lane & 15, fq = lane >> 4;
    const int K = g.K, nt = K / BK;
    unsigned voffA[2], voffB[2];
#pragma unroll
    for (int i = 0; i < 2; ++i) { int R, C; stage_rc(tid * 16 + i * 8192, R, C); const int Rb = Epi::PERM ? ((R & ~31) + perm32(R & 31)) : R;
        voffA[i] = (unsigned)(R * g.lda + C) * 2u; voffB[i] = (unsigned)(Rb * g.ldb + C) * 2u; }
    const size_t kstep = (size_t)(BK * 2);
    const size_t hstepA = (size_t)HALF * g.lda * 2, hstepB = (size_t)HALF * g.ldb * 2;
    const size_t tstepA = 2 * hstepA, tstepB = 2 * hstepB;
    const unsigned ldsw = (unsigned)wid * 1024u;
    const int aoff = lds_byte(wr * 64 + fr, fq * 8), boff = lds_byte(wc * 32 + fr, fq * 8);
#define PG8_SA(b, h) (((b) * 2 + (h)) * HTB)
#define PG8_SB(b, h) ((4 + (b) * 2 + (h)) * HTB)
#define PG8_STAGE(bufoff, gbase, voff) do { _Pragma("unroll") for (int _i = 0; _i < 2; ++_i) \
        __builtin_amdgcn_global_load_lds((const unsigned*)((const char*)(gbase) + (voff)[_i]), (LAS unsigned*)(lds + (bufoff) + ldsw + _i * 8192), 16, 0, 0); } while (0)
#define PG8_LDA(dst, b, h) do { _Pragma("unroll") for (int m = 0; m < 4; ++m) _Pragma("unroll") for (int k = 0; k < 2; ++k) dst[m][k] = *(const LAS bf16x8*)(lds + PG8_SA(b, h) + aoff + m * 2048 + k * 1024); } while (0)
#define PG8_LDB(dst, b, h) do { _Pragma("unroll") for (int n = 0; n < 2; ++n) _Pragma("unroll") for (int k = 0; k < 2; ++k) dst[n][k] = *(const LAS bf16x8*)(lds + PG8_SB(b, h) + boff + n * 2048 + k * 1024); } while (0)
#define PG8_MMA(ai, bj, At, Bt) do { __builtin_amdgcn_s_setprio(1); _Pragma("unroll") for (int m = 0; m < 4; ++m) _Pragma("unroll") for (int n = 0; n < 2; ++n) _Pragma("unroll") for (int k = 0; k < 2; ++k) \
        acc[ai][bj][m][n] = __builtin_amdgcn_mfma_f32_16x16x32_bf16(Bt[n][k], At[m][k], acc[ai][bj][m][n], 0, 0, 0); __builtin_amdgcn_s_setprio(0); } while (0)
#define PG8_WAIT_V(n) asm volatile("s_waitcnt vmcnt(" #n ")" ::: "memory")
#define PG8_WAIT_L(n) asm volatile("s_waitcnt lgkmcnt(" #n ")" ::: "memory")
#define PG8_BAR __builtin_amdgcn_s_barrier()
#define PG8_SCHED __builtin_amdgcn_sched_barrier(0)
    Unit cur, nxt; int ui = 0;
    if (!S.next(0, cur)) return;
    f32x4 acc[2][2][4][2];
#pragma unroll
    for (int a = 0; a < 2; ++a)
#pragma unroll
        for (int b = 0; b < 2; ++b)
#pragma unroll
            for (int m = 0; m < 4; ++m)
#pragma unroll
                for (int n = 0; n < 2; ++n) acc[a][b][m][n] = (f32x4){0.f, 0.f, 0.f, 0.f};
    bf16x8 At[4][2], B0[2][2], B1[2][2];
    const char* cA = (const char*)g.A + (size_t)cur.pm * tstepA; const char* cB = (const char*)g.Bt + (size_t)cur.pn * tstepB;
    if constexpr (SP2) {
        PG8_STAGE(PG8_SB(0, 0), cB, voffB); PG8_STAGE(PG8_SB(0, 1), cB + hstepB, voffB); PG8_STAGE(PG8_SA(0, 0), cA, voffA); PG8_STAGE(PG8_SA(0, 1), cA + hstepA, voffA);
        if (wr == 1) PG8_BAR;
        PG8_WAIT_V(2); PG8_BAR;
        PG8_STAGE(PG8_SB(1, 0), cB + kstep, voffB); PG8_STAGE(PG8_SA(1, 0), cA + kstep, voffA); PG8_STAGE(PG8_SB(1, 1), cB + hstepB + kstep, voffB);
        PG8_WAIT_V(6); PG8_BAR;
    } else {
    PG8_STAGE(PG8_SB(0, 0), cB, voffB); PG8_STAGE(PG8_SA(0, 0), cA, voffA); PG8_STAGE(PG8_SB(0, 1), cB + hstepB, voffB); PG8_STAGE(PG8_SA(0, 1), cA + hstepA, voffA);
    if (wr == 1) PG8_BAR;
    PG8_WAIT_V(4); PG8_BAR;
    PG8_STAGE(PG8_SB(1, 0), cB + kstep, voffB); PG8_STAGE(PG8_SA(1, 0), cA + kstep, voffA); PG8_STAGE(PG8_SB(1, 1), cB + hstepB + kstep, voffB);
    PG8_WAIT_V(6); PG8_BAR;
    }
    for (;;) {
        const bool has_next = S.next(ui + 1, nxt);
        const char* nA = has_next ? (const char*)g.A + (size_t)nxt.pm * tstepA : cA; const char* nB = has_next ? (const char*)g.Bt + (size_t)nxt.pn * tstepB : cB;
        for (int t = 0; t < nt; t += 2) {
            const bool last = (t == nt - 2);
            const char* a1 = cA + (size_t)(t + 1) * kstep;
            const char* a2 = last ? nA : cA + (size_t)(t + 2) * kstep; const char* b2 = last ? nB : cB + (size_t)(t + 2) * kstep;
            const char* a3 = a2 + kstep; const char* b3 = b2 + kstep;
            if (Epi::MID) { if (t == (nt >> 1)) {
                if constexpr (ALIGN_EPI) { if (wr == 0) PG8_BAR; }
                E.mid(acc, cur, wr, wc, fr, fq);
                if constexpr (ALIGN_EPI) { if (wr == 1) PG8_BAR; } } }
            if constexpr (SP2) {
            PG8_LDB(B0, 0, 0); PG8_LDB(B1, 0, 1); PG8_SCHED; PG8_LDA(At, 0, 0); PG8_STAGE(PG8_SA(1, 1), a1 + hstepA, voffA);
            PG8_WAIT_V(8); PG8_WAIT_L(0); PG8_BAR; PG8_MMA(0, 0, At, B0); PG8_MMA(0, 1, At, B1); PG8_BAR; PG8_SCHED;
            PG8_LDA(At, 0, 1); PG8_STAGE(PG8_SB(0, 0), b2, voffB); PG8_STAGE(PG8_SB(0, 1), b2 + hstepB, voffB); PG8_STAGE(PG8_SA(0, 0), a2, voffA);
            PG8_WAIT_V(8); PG8_WAIT_L(0); PG8_BAR; PG8_MMA(1, 0, At, B0); PG8_MMA(1, 1, At, B1); PG8_BAR; PG8_SCHED;
            PG8_LDB(B0, 1, 0); PG8_LDB(B1, 1, 1); PG8_SCHED; PG8_LDA(At, 1, 0); PG8_STAGE(PG8_SA(0, 1), a2 + hstepA, voffA);
            PG8_WAIT_V(8); PG8_WAIT_L(0); PG8_BAR; PG8_MMA(0, 0, At, B0); PG8_MMA(0, 1, At, B1); PG8_BAR; PG8_SCHED;
            PG8_LDA(At, 1, 1); PG8_STAGE(PG8_SB(1, 0), b3, voffB); PG8_STAGE(PG8_SB(1, 1), b3 + hstepB, voffB); PG8_STAGE(PG8_SA(1, 0), a3, voffA);
            PG8_WAIT_V(8); PG8_WAIT_L(0); PG8_BAR; PG8_MMA(1, 0, At, B0); PG8_MMA(1, 1, At, B1); PG8_BAR; PG8_SCHED;
            } else {
            PG8_LDB(B0, 0, 0); PG8_SCHED; PG8_LDA(At, 0, 0); PG8_STAGE(PG8_SA(1, 1), a1 + hstepA, voffA);
            PG8_WAIT_L(8); PG8_BAR; PG8_WAIT_L(0); PG8_MMA(0, 0, At, B0); PG8_BAR; PG8_SCHED;
            PG8_LDB(B1, 0, 1); PG8_STAGE(PG8_SB(0, 0), b2, voffB);
            PG8_BAR; PG8_WAIT_L(0); PG8_MMA(0, 1, At, B1); PG8_BAR;
            PG8_LDA(At, 0, 1); PG8_STAGE(PG8_SA(0, 0), a2, voffA);
            PG8_BAR; PG8_WAIT_L(0); PG8_MMA(1, 0, At, B0); PG8_BAR; PG8_SCHED;
            PG8_STAGE(PG8_SB(0, 1), b2 + hstepB, voffB);
            PG8_WAIT_V(6); PG8_BAR; PG8_MMA(1, 1, At, B1); PG8_BAR;
            PG8_LDB(B0, 1, 0); PG8_SCHED; PG8_LDA(At, 1, 0); PG8_STAGE(PG8_SA(0, 1), a2 + hstepA, voffA);
            PG8_WAIT_L(8); PG8_BAR; PG8_WAIT_L(0); PG8_MMA(0, 0, At, B0); PG8_BAR; PG8_SCHED;
            PG8_LDB(B1, 1, 1); PG8_STAGE(PG8_SB(1, 0), b3, voffB);
            PG8_BAR; PG8_WAIT_L(0); PG8_MMA(0, 1, At, B1); PG8_BAR;
            PG8_LDA(At, 1, 1); PG8_STAGE(PG8_SA(1, 0), a3, voffA);
            PG8_BAR; PG8_WAIT_L(0); PG8_MMA(1, 0, At, B0); PG8_BAR; PG8_SCHED;
            PG8_STAGE(PG8_SB(1, 1), b3 + hstepB, voffB);
            PG8_WAIT_V(6); PG8_BAR; PG8_MMA(1, 1, At, B1); PG8_BAR;
            }
        }
        if constexpr (ALIGN_EPI) { if (wr == 0) PG8_BAR; }
        E(acc, cur, wr, wc, fr, fq);
        if (!has_next) break;
#pragma unroll
        for (int a = 0; a < 2; ++a)
#pragma unroll
            for (int b = 0; b < 2; ++b)
#pragma unroll
                for (int m = 0; m < 4; ++m)
#pragma unroll
                    for (int n = 0; n < 2; ++n) acc[a][b][m][n] = (f32x4){0.f, 0.f, 0.f, 0.f};
        cur = nxt; cA = nA; cB = nB; ++ui;
        if constexpr (ALIGN_EPI) { if (wr == 1) PG8_BAR; }
    }
    PG8_WAIT_V(0);
    if constexpr (!ALIGN_EPI) { if (wr == 0) PG8_BAR; }
    PG8_BAR;
#undef PG8_SA
#undef PG8_SB
#undef PG8_STAGE
#undef PG8_LDA
#undef PG8_LDB
#undef PG8_MMA
#undef PG8_WAIT_V
#undef PG8_WAIT_L
#undef PG8_BAR
#undef PG8_SCHED
}
}

#define XB_TMO      128
#define XB_XCNT(j)  (256  + 64 * (j))
#define XB_XSUB(j)  (1280 + 64 * (j))
#define XB_XGEN(j)  (2304 + 64 * (j))
#define XB_TOP      3328
#define XB_TOPGEN   3392
#define XCD_BAR_WORDS 3456
#define XB_SPIN_CAP (1u << 18)

__device__ __forceinline__ unsigned xb_ld(unsigned* p)              { return __hip_atomic_load(p, __ATOMIC_RELAXED, __HIP_MEMORY_SCOPE_AGENT); }
__device__ __forceinline__ unsigned xb_add(unsigned* p, unsigned v) { return __hip_atomic_fetch_add(p, v, __ATOMIC_RELAXED, __HIP_MEMORY_SCOPE_AGENT); }
__device__ __forceinline__ unsigned xb_xcc_id() { return (unsigned)__builtin_amdgcn_s_getreg((3 << 11) | 20) & 0xFu; }
#define XB_SPIN(cond, bar) do { unsigned _sp = 0; while (cond) { __builtin_amdgcn_s_sleep(1); \
    if ((++_sp & 255u) == 0u) { if (xb_ld(&(bar)[XB_TMO])) break; if (_sp > XB_SPIN_CAP) { atomicAdd(&(bar)[XB_TMO], 1u); break; } } } } while (0)

struct XcdBarrier {
    unsigned* bar; unsigned x;
    volatile LAS unsigned* st;
};

__device__ __forceinline__ XcdBarrier xcd_barrier_post(unsigned* bar, volatile LAS unsigned* st) {
    XcdBarrier b; b.bar = bar; b.x = xb_xcc_id(); b.st = st;
    if (threadIdx.x == 0) (void)xb_add(&bar[XB_XCNT(b.x)], 1u);
    return b;
}
__device__ __forceinline__ void xcd_barrier_complete(unsigned* bar, unsigned x, unsigned& nloc, unsigned& nx) {
    const unsigned G = gridDim.x * gridDim.y * gridDim.z;
    unsigned sum, cnt, mine, sp = 0u;
    for (;;) {
        sum = 0u; cnt = 0u; mine = 0u;
#pragma unroll
        for (unsigned j = 0; j < 16; ++j) { const unsigned c = xb_ld(&bar[XB_XCNT(j)]); sum += c; cnt += (c > 0u) ? 1u : 0u; mine = (j == x) ? c : mine; }
        if (sum == G) break;
        __builtin_amdgcn_s_sleep(1);
        if ((++sp & 255u) == 0u) { if (xb_ld(&bar[XB_TMO])) break; if (sp > XB_SPIN_CAP) { atomicAdd(&bar[XB_TMO], 1u); break; } }
    }
    nloc = mine > 0u ? mine : 1u; nx = cnt > 0u ? cnt : 1u;
}

__device__ __forceinline__ void xcd_barrier(const XcdBarrier& b) {
    asm volatile("s_waitcnt vmcnt(0)" ::: "memory");
    __syncthreads();
    if (threadIdx.x == 0) {
        unsigned* bar = b.bar;
        __builtin_amdgcn_s_waitcnt(0);
        unsigned nloc = b.st[0], nx = b.st[1];
        if (nloc == 0u) { xcd_barrier_complete(bar, b.x, nloc, nx); b.st[0] = nloc; b.st[1] = nx; }
        const unsigned old = xb_add(&bar[XB_XSUB(b.x)], 1u);
        const unsigned gen = old / nloc;
        if (old + 1u == (gen + 1u) * nloc) {
            __builtin_amdgcn_fence(__ATOMIC_RELEASE, "agent");
            asm volatile("s_waitcnt vmcnt(0)" ::: "memory");
            const unsigned og = xb_add(&bar[XB_TOP], 1u);
            const unsigned tg = og / nx;
            if (og + 1u == (tg + 1u) * nx) xb_add(&bar[XB_TOPGEN], 1u);
            else XB_SPIN(xb_ld(&bar[XB_TOPGEN]) == tg, bar);
            __builtin_amdgcn_fence(__ATOMIC_ACQUIRE, "agent");
            xb_add(&bar[XB_XGEN(b.x)], 1u);
            asm volatile("s_waitcnt vmcnt(0)" ::: "memory");
        } else {
            XB_SPIN(xb_ld(&bar[XB_XGEN(b.x)]) == gen, bar);
            __builtin_amdgcn_fence(__ATOMIC_ACQUIRE, "agent");
            asm volatile("s_waitcnt vmcnt(0)" ::: "memory");
        }
    }
    __syncthreads();
}


struct Args {
    const float* x; const int* pos; const float* g_pre; const float* w_in; const float* g_q_lat; const float* g_kv_lat; const float* w_uq; const float* w_ukv;
    const float* g_qn_a; const float* g_kn_a; const float* g_qn_b; const float* g_kn_b; const float* t5; const float* p_a; const float* p_b; const float* w_o;
    float* out; unsigned char* ws; int ph_lo, ph_hi;
};

DI void p0_transpose_item(const float* W, int N, const float* gk, bf16_t* WT, int ldk, int koff, LAS float* scr, int item, int lane) {
    const int nblk = (N + 63) / 64, kb = item / nblk, nb = item % nblk, k0 = 64 * kb, n0 = 64 * nb;
    const bool nv = (n0 + lane) < N;
    const float* wp = W + (size_t)k0 * N + n0 + (nv ? lane : 0);
    float wv_[64];
#pragma unroll
    for (int i = 0; i < 64; ++i) wv_[i] = wp[(size_t)i * N];
#pragma unroll
    for (int i = 0; i < 64; ++i) { float v = nv ? wv_[i] : 0.f; if (gk) v *= gk[k0 + i]; scr[i * 65 + lane] = v; }
    asm volatile("s_waitcnt lgkmcnt(0)" ::: "memory");
    const int c = lane & 7;
#pragma unroll
    for (int j = 0; j < 8; ++j) { const int n = (lane >> 3) + 8 * j; const LAS float* s = scr + (8 * c) * 65 + n;
        u32x4 o; o.x = pk2(s[0 * 65], s[1 * 65]); o.y = pk2(s[2 * 65], s[3 * 65]); o.z = pk2(s[4 * 65], s[5 * 65]); o.w = pk2(s[6 * 65], s[7 * 65]);
        if (n0 + n < N) *(u32x4*)(WT + (size_t)(n0 + n) * ldk + koff + k0 + 8 * c) = o; }
    asm volatile("s_waitcnt lgkmcnt(0)" ::: "memory");
}
DI void p0_prologue(const Args& a, LAS unsigned char* lds, int G) {
    const int tid = threadIdx.x, lane = tid & 63, wave = tid >> 6;
    LAS float* scr = (LAS float*)(lds + wave * 16640);
    const int gw = blockIdx.x * NWAVES + wave, NGW = G * NWAVES;
    bf16_t* WIN_T = (bf16_t*)(a.ws + WS_WIN_T); bf16_t* WUQ_T = (bf16_t*)(a.ws + WS_WUQ_T); bf16_t* WUKV_T = (bf16_t*)(a.ws + WS_WUKV_T);
    bf16_t* PCAT_T = (bf16_t*)(a.ws + WS_PCAT_T); bf16_t* WO_T = (bf16_t*)(a.ws + WS_WO_T); bf16_t* HN = (bf16_t*)(a.ws + WS_HN);
    constexpr int I_IN = (DM / 64) * ((NCOLS + 63) / 64), I_UQ = (1024 / 64) * (3072 / 64), I_UKV = (512 / 64) * (4096 / 64), I_P = (2048 / 64) * (4096 / 64), I_O = (4096 / 64) * (4096 / 64);
    constexpr int NITEMS = I_IN + I_UQ + I_UKV + 2 * I_P + I_O;
    for (int it = gw; it < NITEMS; it += NGW) {
        int r = it;
        if (r < I_IN) { p0_transpose_item(a.w_in, NCOLS, nullptr, WIN_T, DM, 0, scr, r, lane); continue; } r -= I_IN;
        if (r < I_UQ) { p0_transpose_item(a.w_uq, 3072, a.g_q_lat, WUQ_T, 1024, 0, scr, r, lane); continue; } r -= I_UQ;
        if (r < I_UKV) { p0_transpose_item(a.w_ukv, 4096, a.g_kv_lat, WUKV_T, 512, 0, scr, r, lane); continue; } r -= I_UKV;
        if (r < I_P) { p0_transpose_item(a.p_a, 4096, nullptr, PCAT_T, 4096, 0, scr, r, lane); continue; } r -= I_P;
        if (r < I_P) { p0_transpose_item(a.p_b, 4096, nullptr, PCAT_T, 4096, 2048, scr, r, lane); continue; } r -= I_P;
        p0_transpose_item(a.w_o, 4096, nullptr, WO_T, 4096, 0, scr, r, lane);
    }
    { u32x4* z = (u32x4*)(WIN_T + (size_t)NCOLS * DM); const int n16 = (LDP - NCOLS) * DM * 2 / 16;
      for (int i = blockIdx.x * NTHREADS + tid; i < n16; i += G * NTHREADS) z[i] = (u32x4){0u, 0u, 0u, 0u}; }
    for (int m = gw; m < M; m += NGW) {
        const f32x4* xr = (const f32x4*)(a.x + (size_t)m * DM) + lane; const f32x4* gr = (const f32x4*)a.g_pre + lane;
        f32x4 v[16]; float s = 0.f;
#pragma unroll
        for (int j = 0; j < 16; ++j) { v[j] = xr[64 * j]; s += (v[j].x * v[j].x + v[j].y * v[j].y) + (v[j].z * v[j].z + v[j].w * v[j].w); }
        const float rs = rsqrtf(wave_sum(s) * (1.f / DM) + EPS);
        u32x2* o8 = (u32x2*)(HN + (size_t)m * DM) + lane;
#pragma unroll
        for (int j = 0; j < 16; ++j) { const f32x4 g = gr[64 * j]; u32x2 w; w.x = pk2(v[j].x * rs * g.x, v[j].y * rs * g.y); w.y = pk2(v[j].z * rs * g.z, v[j].w * rs * g.w); o8[64 * j] = w; }
    }
}

DI void p3_prep(const Args& a, LAS unsigned char* lds, int G) {
    const int tid = threadIdx.x, lane = tid & 63, wave = tid >> 6, hl = lane & 31, hh = lane >> 5;
    const bf16_t* PROJ = (const bf16_t*)(a.ws + WS_PROJ); const bf16_t* QRAW = (const bf16_t*)(a.ws + WS_WIN_T); const bf16_t* KVRAW = (const bf16_t*)(a.ws + WS_HN);
    bf16_t* QA = (bf16_t*)((unsigned char*)a.out + DO_QA); bf16_t* KA = (bf16_t*)((unsigned char*)a.out + DO_KA); bf16_t* VAT = (bf16_t*)((unsigned char*)a.out + DO_VAT);
    bf16_t* QB = (bf16_t*)(a.ws + WS_QB); bf16_t* KBn = (bf16_t*)(a.ws + WS_KB); bf16_t* VBT = (bf16_t*)(a.ws + WS_VBT); bf16_t* KIDX = (bf16_t*)(a.ws + WS_KIDX);
    LAS unsigned short* tile0 = (LAS unsigned short*)lds;
    LAS float* rskv = (LAS float*)(lds + 81920);
    const f32x4 gqa = *(const f32x4*)(a.g_qn_a + 4 * hl); const float gqa1 = a.g_qn_a[128 + hl], gqa2 = a.g_qn_a[160 + hl];
    const f32x4 gka = *(const f32x4*)(a.g_kn_a + 4 * hl); const float gka1 = a.g_kn_a[128 + hl], gka2 = a.g_kn_a[160 + hl];
    const f32x4 gqb = *(const f32x4*)(a.g_qn_b + 4 * hl); const f32x4 gkb = *(const f32x4*)(a.g_kn_b + 4 * hl);
    const float inv_freq = exp2f(-(float)hl * 0.41524101186092029f);
    for (int tl0 = blockIdx.x; tl0 < M / 64; tl0 += G) {
        const int m0 = tl0 * 64;
#pragma unroll 1
        for (int i = 0; i < 8; ++i) {
            const int tl = wave * 8 + i, m = m0 + tl, b = m / L, l = m % L;
            const bf16_t* pr = PROJ + (size_t)m * LDP;
            const u32x4 c0 = *(const u32x4*)(pr + C_CQ + lane * 16), c1 = *(const u32x4*)(pr + C_CQ + lane * 16 + 8), c2 = *(const u32x4*)(pr + C_CKV + lane * 8);
            const int posm = a.pos[m];
            const unsigned short kr1u = pr[C_KROPE + hl], kr2u = pr[C_KROPE + 32 + hl];
            const u32x2 wkb = *(const u32x2*)(pr + C_KB + 4 * hl);
            u32x2 wki = (u32x2){0u, 0u}; if (lane < 16) wki = *(const u32x2*)(pr + C_KIDX + 4 * lane);
            u32x2 wqa[8], wka[8], wqb[8]; unsigned short q1u[8], q2u[8];
#pragma unroll
            for (int hp = 0; hp < 8; ++hp) { const int head = 2 * hp + hh;
                const bf16_t* sq = QRAW + (size_t)m * 3072 + head * 192; const bf16_t* sk = KVRAW + (size_t)m * 4096 + head * 256;
                wqa[hp] = *(const u32x2*)(sq + 4 * hl); q1u[hp] = sq[128 + hl]; q2u[hp] = sq[160 + hl];
                wka[hp] = *(const u32x2*)(sk + 4 * hl); wqb[hp] = *(const u32x2*)(pr + C_QB + head * 128 + 4 * hl); }
            __builtin_amdgcn_sched_barrier(0);
            const float rs_q = rsqrtf(wave_sum(sumsq8(c0) + sumsq8(c1)) * (1.f / 1024.f) + EPS);
            const float rs_kv = rsqrtf(wave_sum(sumsq8(c2)) * (1.f / 512.f) + EPS);
            if (lane == 0) rskv[tl] = rs_kv;
            const float ang = (float)posm * inv_freq;
            double tt = (double)ang * 0.15915494309189535; tt -= floor(tt); const float frac = (float)tt;
            const float cs = __builtin_amdgcn_cosf(frac), sn = __builtin_amdgcn_sinf(frac);
            const float kr1 = bf2f(kr1u), kr2 = bf2f(kr2u);
#pragma unroll
            for (int hp = 0; hp < 8; ++hp) {
                const int head = 2 * hp + hh;
                {
                    const u32x2 w = wqa[hp];
                    const float x0 = lo16(w.x) * rs_q, x1 = hi16(w.x) * rs_q, x2 = lo16(w.y) * rs_q, x3 = hi16(w.y) * rs_q;
                    const float r1 = bf2f(q1u[hp]) * rs_q, r2 = bf2f(q2u[hp]) * rs_q;
                    const float ss = half_sum((x0 * x0 + x1 * x1) + (x2 * x2 + x3 * x3) + (r1 * r1 + r2 * r2));
                    const float ri = rsqrtf(ss * (1.f / 192.f) + EPS);
                    const float y1 = r1 * ri * gqa1, y2 = r2 * ri * gqa2;
                    const float o1 = (y1 * cs - y2 * sn) * QSA, o2 = (y1 * sn + y2 * cs) * QSA;
                    bf16_t* dst = QA + ((size_t)(b * 16 + head) * L + l) * 192;
                    u32x2 o; o.x = pk2(x0 * ri * gqa.x * QSA, x1 * ri * gqa.y * QSA); o.y = pk2(x2 * ri * gqa.z * QSA, x3 * ri * gqa.w * QSA);
                    *(u32x2*)(dst + 4 * hl) = o; dst[128 + hl] = (bf16_t)(pk2(o1, 0.f) & 0xffffu); dst[160 + hl] = (bf16_t)(pk2(o2, 0.f) & 0xffffu);
                }
                {
                    const u32x2 w = wka[hp];
                    const float x0 = lo16(w.x) * rs_kv, x1 = hi16(w.x) * rs_kv, x2 = lo16(w.y) * rs_kv, x3 = hi16(w.y) * rs_kv;
                    const float ss = half_sum((x0 * x0 + x1 * x1) + (x2 * x2 + x3 * x3) + (kr1 * kr1 + kr2 * kr2));
                    const float ri = rsqrtf(ss * (1.f / 192.f) + EPS);
                    const float y1 = kr1 * ri * gka1, y2 = kr2 * ri * gka2;
                    const float o1 = y1 * cs - y2 * sn, o2 = y1 * sn + y2 * cs;
                    bf16_t* dst = KA + ((size_t)(b * 16 + head) * L + l) * 192;
                    u32x2 o; o.x = pk2(x0 * ri * gka.x, x1 * ri * gka.y); o.y = pk2(x2 * ri * gka.z, x3 * ri * gka.w);
                    *(u32x2*)(dst + 4 * hl) = o; dst[128 + hl] = (bf16_t)(pk2(o1, 0.f) & 0xffffu); dst[160 + hl] = (bf16_t)(pk2(o2, 0.f) & 0xffffu);
                }
                {
                    const u32x2 w = wqb[hp];
                    const float x0 = lo16(w.x), x1 = hi16(w.x), x2 = lo16(w.y), x3 = hi16(w.y);
                    const float ss = half_sum((x0 * x0 + x1 * x1) + (x2 * x2 + x3 * x3));
                    const float ri = rsqrtf(ss * (1.f / 128.f) + EPS) * QSB;
                    u32x2 o; o.x = pk2(x0 * ri * gqb.x, x1 * ri * gqb.y); o.y = pk2(x2 * ri * gqb.z, x3 * ri * gqb.w);
                    *(u32x2*)(QB + ((size_t)m * 16 + head) * 128 + 4 * hl) = o;
                }
            }
            {
                const u32x2 w = wkb;
                const float x0 = lo16(w.x), x1 = hi16(w.x), x2 = lo16(w.y), x3 = hi16(w.y);
                const float ss = half_sum((x0 * x0 + x1 * x1) + (x2 * x2 + x3 * x3));
                const float ri = rsqrtf(ss * (1.f / 128.f) + EPS);
                u32x2 o; o.x = pk2(x0 * ri * gkb.x, x1 * ri * gkb.y); o.y = pk2(x2 * ri * gkb.z, x3 * ri * gkb.w);
                if (hh == 0) *(u32x2*)(KBn + (size_t)m * 128 + 4 * hl) = o;
            }
            if (lane < 16) *(u32x2*)(KIDX + (size_t)m * 64 + 4 * lane) = wki;
        }
        __syncthreads();
        const int b = m0 / L, l0 = m0 % L;
        for (int mat0 = 0; mat0 < 17; mat0 += 4) {
#pragma unroll
            for (int mm = 0; mm < 4; ++mm) { const int mat = mat0 + mm; if (mat < 17) {
                const int tl = tid >> 3, ch = tid & 7; LAS unsigned short* tile = tile0 + mm * (64 * 136);
                const bf16_t* src = (mat < 16) ? (KVRAW + (size_t)(m0 + tl) * 4096 + mat * 256 + 128 + 16 * ch) : (PROJ + (size_t)(m0 + tl) * LDP + C_VB + 16 * ch);
                const u32x4 v0 = *(const u32x4*)src, v1 = *(const u32x4*)(src + 8);
                *(LAS u32x4*)(tile + tl * 136 + 16 * ch) = v0; *(LAS u32x4*)(tile + tl * 136 + 16 * ch + 8) = v1; } }
            __syncthreads();
#pragma unroll
            for (int mm = 0; mm < 4; ++mm) { const int mat = mat0 + mm; if (mat < 17) {
                const int d = tid >> 2, tg = tid & 3; float f[16]; const LAS unsigned short* tile = tile0 + mm * (64 * 136);
#pragma unroll
                for (int i = 0; i < 16; ++i) { const float sc = (mat < 16) ? rskv[16 * tg + i] : 1.f; f[i] = bf2f(tile[(16 * tg + i) * 136 + d]) * sc; }
                bf16_t* dst = ((mat < 16) ? (VAT + ((size_t)(b * 16 + mat) * 128 + d) * L) : (VBT + ((size_t)b * 128 + d) * L)) + l0 + 16 * tg;
                u32x4 w0, w1; w0.x = pk2(f[0], f[1]); w0.y = pk2(f[2], f[3]); w0.z = pk2(f[4], f[5]); w0.w = pk2(f[6], f[7]);
                w1.x = pk2(f[8], f[9]); w1.y = pk2(f[10], f[11]); w1.z = pk2(f[12], f[13]); w1.w = pk2(f[14], f[15]);
                *(u32x4*)dst = w0; *(u32x4*)(dst + 8) = w1; } }
            __syncthreads();
        }
    }
}

constexpr int VT_PITCH = 136, VT_BYTES = 128 * VT_PITCH;
constexpr int ATT_TB_OFF = 131072, ATT_MASK_OFF = ATT_TB_OFF + 129 * 16 * 4, ATT_KST_OFF = ATT_MASK_OFF + 4096;
static_assert(ATT_KST_OFF + 16384 <= LDS_BYTES, "LDS map");
DI float silu(float g) { return g * __builtin_amdgcn_rcpf(1.f + __expf(-g)); }

#define ATT_WRITE_NEXT() do { if (pre) { LAS unsigned char* kbn = kbase + (buf ^ 1) * KT_BYTES; LAS unsigned char* vbn = vbase + (buf ^ 1) * VT_BYTES; \
            _Pragma("unroll") for (int i = 0; i < KCH; ++i) *(LAS u32x4*)(kbn + klo0 + 2048 * i) = kreg[i]; \
            _Pragma("unroll") for (int i = 0; i < 2; ++i) { *(LAS u32x2*)(vbn + vlo0 + 64 * VT_PITCH * i) = (u32x2){vreg[i].x, vreg[i].y}; *(LAS u32x2*)(vbn + vlo0 + 64 * VT_PITCH * i + 8) = (u32x2){vreg[i].z, vreg[i].w}; } } } while (0)
template <int DQK, bool MB>
DI void attn_core(LAS unsigned char* lds, const bf16_t* Kg, const bf16_t* Vtg, const bf16_t* q0p, const bf16_t* q1p, int nt, int qi0, int qi1, int wave_qmax,
                  const LAS unsigned long long* sm0, const LAS unsigned long long* sm1, const LAS float* tb, const int* posb, int pt0, int pt1,
                  f32x4 (&o)[2][8], float (&lsum)[2]) {
    constexpr int KK = DQK / 32, KT_BYTES = 64 * DQK * 2, KCH = (64 * DQK / 8) / NTHREADS, DCH = DQK / 8;
    int tid_o = threadIdx.x; asm volatile("" : "+v"(tid_o));
    const int tid = tid_o, lane = tid & 63, r = lane & 15, q = lane >> 4;
    constexpr bool ST = false;
    constexpr int NBUF = ST ? 3 : 2, AHEAD = ST ? 2 : 1;
    LAS unsigned char* kbase = lds; LAS unsigned char* vbase = lds + NBUF * KT_BYTES;
    constexpr int KR = 0, KH = KK - KR;
    bf16x8 qf[2][KH];
#pragma unroll
    for (int kk = 0; kk < KH; ++kk) { qf[0][kk] = *(const bf16x8*)(q0p + 32 * kk + 8 * q); qf[1][kk] = *(const bf16x8*)(q1p + 32 * kk + 8 * q); }
#pragma unroll
    for (int ct = 0; ct < 2; ++ct) { lsum[ct] = 0.f;
#pragma unroll
        for (int dt = 0; dt < 8; ++dt) o[ct][dt] = (f32x4){0.f, 0.f, 0.f, 0.f}; }
    float mrow[2] = {-1e30f, -1e30f};
    float tbfar = 0.f; if (MB) tbfar = tb[128 * 16 + r];
    const int skey = tid >> 3, sch = tid & 7;
    const int kgo0 = skey * DQK + sch * 8;
    int klo0; { const int st = (skey >> 4) * KK + (sch >> 2), ob = (skey & 15) * 64 + (sch & 3) * 16; klo0 = st * 1024 + (ob ^ (((ob >> 9) & 1) << 5)); }
    const int vgo0 = skey * L + sch * 8, vlo0 = skey * VT_PITCH + sch * 16;
    u32x4 kreg[KCH], vreg[2];
#pragma unroll
    for (int i = 0; i < KCH; ++i) kreg[i] = *(const u32x4*)(Kg + kgo0 + 64 * i);
#pragma unroll
    for (int i = 0; i < 2; ++i) vreg[i] = *(const u32x4*)(Vtg + vgo0 + 64 * i * L);
#pragma unroll
    for (int i = 0; i < KCH; ++i) *(LAS u32x4*)(kbase + klo0 + 2048 * i) = kreg[i];
#pragma unroll
    for (int i = 0; i < 2; ++i) { *(LAS u32x2*)(vbase + vlo0 + 64 * VT_PITCH * i) = (u32x2){vreg[i].x, vreg[i].y}; *(LAS u32x2*)(vbase + vlo0 + 64 * VT_PITCH * i + 8) = (u32x2){vreg[i].z, vreg[i].w}; }
    if (ST && nt > 1) {
#pragma unroll
        for (int i = 0; i < KCH; ++i) kreg[i] = *(const u32x4*)(Kg + (size_t)64 * DQK + kgo0 + 64 * i);
#pragma unroll
        for (int i = 0; i < 2; ++i) vreg[i] = *(const u32x4*)(Vtg + 64 + vgo0 + 64 * i * L);
#pragma unroll
        for (int i = 0; i < KCH; ++i) *(LAS u32x4*)(kbase + KT_BYTES + klo0 + 2048 * i) = kreg[i];
#pragma unroll
        for (int i = 0; i < 2; ++i) { *(LAS u32x2*)(vbase + VT_BYTES + vlo0 + 64 * VT_PITCH * i) = (u32x2){vreg[i].x, vreg[i].y}; *(LAS u32x2*)(vbase + VT_BYTES + vlo0 + 64 * VT_PITCH * i + 8) = (u32x2){vreg[i].z, vreg[i].w}; }
    }
    __syncthreads();
    const int grp = __builtin_amdgcn_readfirstlane(tid >> 8);
#pragma unroll
    for (int kk = 0; kk < KH; ++kk) asm volatile("" :: "v"(qf[0][kk]), "v"(qf[1][kk]));
    if (ST && grp == 1) { asm volatile("" ::: "memory"); __builtin_amdgcn_s_barrier(); asm volatile("" ::: "memory"); }
    const int ob0 = r * 64 + q * 16, koff = ob0 ^ (((ob0 >> 9) & 1) << 5);
    int kt_far = nt;
    if (MB) { const int tl = (lane < nt) ? lane : (nt - 1); const int pl = posb[64 * tl + 63];
        kt_far = __popcll(__ballot(lane < nt && (pt0 - pl) >= 128)); }
    int buf = 0;
#pragma unroll
    for (int pass = 0; pass < (MB ? 2 : 1); ++pass)
    for (int kt = (pass == 0 ? 0 : kt_far); kt < ((MB && pass == 0) ? kt_far : nt); ++kt) {
        const bool pre = (kt + AHEAD < nt);
        if (pre) {
#pragma unroll
            for (int i = 0; i < KCH; ++i) kreg[i] = *(const u32x4*)(Kg + (size_t)(kt + AHEAD) * 64 * DQK + kgo0 + 64 * i);
#pragma unroll
            for (int i = 0; i < 2; ++i) vreg[i] = *(const u32x4*)(Vtg + (kt + AHEAD) * 64 + vgo0 + 64 * i * L);
        }
        const bool act = MB || 64 * kt <= wave_qmax;
        const LAS unsigned char* kb = kbase + buf * KT_BYTES; const LAS unsigned char* vb = vbase + buf * VT_BYTES;
        f32x4 s[4][2];
        if (act) {
            bf16x8 kfa[KK], kfb[KK];
#pragma unroll
            for (int kk = 0; kk < KK; ++kk) kfa[kk] = *(const LAS bf16x8*)(kb + kk * 1024 + koff);
#pragma unroll
            for (int ks = 0; ks < 4; ++ks) {
                if (ks < 3) {
#pragma unroll
                    for (int kk = 0; kk < KK; ++kk) { const bf16x8 t = *(const LAS bf16x8*)(kb + ((ks + 1) * KK + kk) * 1024 + koff); if (ks & 1) kfa[kk] = t; else kfb[kk] = t; }
                }
                __builtin_amdgcn_sched_barrier(0);
                __builtin_amdgcn_s_setprio(1);
                s[ks][0] = (f32x4){0.f, 0.f, 0.f, 0.f}; s[ks][1] = (f32x4){0.f, 0.f, 0.f, 0.f};
#pragma unroll
                for (int kk = 0; kk < KK; ++kk) { const bf16x8 kf = (ks & 1) ? kfb[kk] : kfa[kk];
                    const bf16x8 qa0 = qf[0][kk], qa1 = qf[1][kk];
                    s[ks][0] = __builtin_amdgcn_mfma_f32_16x16x32_bf16(kf, qa0, s[ks][0], 0, 0, 0);
                    s[ks][1] = __builtin_amdgcn_mfma_f32_16x16x32_bf16(kf, qa1, s[ks][1], 0, 0, 0); }
                __builtin_amdgcn_s_setprio(0);
                __builtin_amdgcn_sched_barrier(0);
            }
        }
        if (ST) { asm volatile("" ::: "memory"); __builtin_amdgcn_s_barrier(); asm volatile("" ::: "memory"); }
        if (act) {
            if (MB) {
                const unsigned long long mw0 = sm0[kt], mw1 = sm1[kt];
                if (pass == 0) {
#pragma unroll
                    for (int ks = 0; ks < 4; ++ks) { const unsigned b0 = (unsigned)(mw0 >> (16 * ks + 4 * q)) & 0xFu, b1 = (unsigned)(mw1 >> (16 * ks + 4 * q)) & 0xFu;
#pragma unroll
                        for (int j = 0; j < 4; ++j) { s[ks][0][j] = ((b0 >> j) & 1u) ? s[ks][0][j] + tbfar : -INFINITY; s[ks][1][j] = ((b1 >> j) & 1u) ? s[ks][1][j] + tbfar : -INFINITY; } }
                } else
                {
                float bv[4][2][4];
#pragma unroll
                for (int ks = 0; ks < 4; ++ks) { const i32x4 pk = *(const i32x4*)(posb + 64 * kt + 16 * ks + 4 * q);
#pragma unroll
                    for (int j = 0; j < 4; ++j) { const int d0 = min(max(pt0 - pk[j], 0), 128), d1 = min(max(pt1 - pk[j], 0), 128);
                        bv[ks][0][j] = tb[d0 * 16 + r]; bv[ks][1][j] = tb[d1 * 16 + r]; } }
                __builtin_amdgcn_sched_barrier(0);
#pragma unroll
                for (int ks = 0; ks < 4; ++ks) { const unsigned b0 = (unsigned)(mw0 >> (16 * ks + 4 * q)) & 0xFu, b1 = (unsigned)(mw1 >> (16 * ks + 4 * q)) & 0xFu;
#pragma unroll
                    for (int j = 0; j < 4; ++j) { s[ks][0][j] = ((b0 >> j) & 1u) ? s[ks][0][j] + bv[ks][0][j] : -INFINITY; s[ks][1][j] = ((b1 >> j) & 1u) ? s[ks][1][j] + bv[ks][1][j] : -INFINITY; } }
                }
            } else if (64 * kt + 63 > wave_qmax - 31) {
#pragma unroll
                for (int ks = 0; ks < 4; ++ks)
#pragma unroll
                    for (int j = 0; j < 4; ++j) { const int key = 64 * kt + 16 * ks + 4 * q + j;
                        s[ks][0][j] = (key <= qi0) ? s[ks][0][j] : -INFINITY; s[ks][1][j] = (key <= qi1) ? s[ks][1][j] : -INFINITY; }
            }
            float alpha2[2];
#pragma unroll
            for (int ct = 0; ct < 2; ++ct) {
                float mx = -INFINITY;
#pragma unroll
                for (int ks = 0; ks < 4; ++ks)
#pragma unroll
                    for (int j = 0; j < 4; ++j) mx = fmaxf(mx, s[ks][ct][j]);
                mx = fmaxf(mx, __shfl_xor(mx, 16)); mx = fmaxf(mx, __shfl_xor(mx, 32));
                const float mnew = fmaxf(mrow[ct], mx), alpha = __builtin_amdgcn_exp2f(mrow[ct] - mnew);
                mrow[ct] = mnew;
                float ps = 0.f;
#pragma unroll
                for (int ks = 0; ks < 4; ++ks)
#pragma unroll
                    for (int j = 0; j < 4; ++j) { const float p = __builtin_amdgcn_exp2f(s[ks][ct][j] - mnew); s[ks][ct][j] = p; ps += p; }
                lsum[ct] = lsum[ct] * alpha + ps; alpha2[ct] = alpha;
            }
            {
#pragma unroll
                for (int ct = 0; ct < 2; ++ct)
#pragma unroll
                    for (int dt = 0; dt < 8; ++dt) o[ct][dt] *= alpha2[ct];
            }
#pragma unroll
            for (int kb2 = 0; kb2 < 2; ++kb2) {
                bf16x8 pb[2];
#pragma unroll
                for (int ct = 0; ct < 2; ++ct) { u32x4 w; w.x = pk2(s[2 * kb2][ct][0], s[2 * kb2][ct][1]); w.y = pk2(s[2 * kb2][ct][2], s[2 * kb2][ct][3]);
                    w.z = pk2(s[2 * kb2 + 1][ct][0], s[2 * kb2 + 1][ct][1]); w.w = pk2(s[2 * kb2 + 1][ct][2], s[2 * kb2 + 1][ct][3]); pb[ct] = __builtin_bit_cast(bf16x8, w); }
                bf16x8 vf[8];
#pragma unroll
                for (int dt = 0; dt < 8; ++dt) { const LAS unsigned char* vp = vb + (16 * dt + r) * VT_PITCH + (32 * kb2 + 4 * q) * 2;
                    const s16x4 lo = *(const LAS s16x4*)vp, hi = *(const LAS s16x4*)(vp + 32);
                    vf[dt] = __builtin_shufflevector(lo, hi, 0, 1, 2, 3, 4, 5, 6, 7); }
                __builtin_amdgcn_sched_barrier(0);
                __builtin_amdgcn_s_setprio(1);
#pragma unroll
                for (int dt = 0; dt < 8; ++dt) {
                    o[0][dt] = __builtin_amdgcn_mfma_f32_16x16x32_bf16(vf[dt], pb[0], o[0][dt], 0, 0, 0);
                    o[1][dt] = __builtin_amdgcn_mfma_f32_16x16x32_bf16(vf[dt], pb[1], o[1][dt], 0, 0, 0); }
                __builtin_amdgcn_s_setprio(0);
                __builtin_amdgcn_sched_barrier(0);
            }
        }
        if (pre) { const int nb = ST ? ((buf == 0) ? 2 : buf - 1) : (buf ^ 1); LAS unsigned char* kbn = kbase + nb * KT_BYTES; LAS unsigned char* vbn = vbase + nb * VT_BYTES;
#pragma unroll
            for (int i = 0; i < KCH; ++i) *(LAS u32x4*)(kbn + klo0 + 2048 * i) = kreg[i];
#pragma unroll
            for (int i = 0; i < 2; ++i) { *(LAS u32x2*)(vbn + vlo0 + 64 * VT_PITCH * i) = (u32x2){vreg[i].x, vreg[i].y}; *(LAS u32x2*)(vbn + vlo0 + 64 * VT_PITCH * i + 8) = (u32x2){vreg[i].z, vreg[i].w}; } }
        __syncthreads();
        buf = ST ? ((buf == 2) ? 0 : buf + 1) : (buf ^ 1);
    }
    if (ST && grp == 0) { asm volatile("" ::: "memory"); __builtin_amdgcn_s_barrier(); asm volatile("" ::: "memory"); }
#pragma unroll
    for (int ct = 0; ct < 2; ++ct) { float l = lsum[ct]; l += __shfl_xor(l, 16); l += __shfl_xor(l, 32); lsum[ct] = l; }
}

DI int crow(int i, int h) { return (i & 3) + 8 * (i >> 2) + 4 * h; }

DI void indexer_unit(LAS unsigned char* lds, LAS unsigned long long* smask_w, const bf16_t* PROJ, const bf16_t* KIDXb, const int* posb, int mb0  , int t_0, int njp, int wave, int lane_in) {
    int lane = lane_in; asm volatile("" : "+v"(lane));
    const int tid = wave * 64 + lane, r = lane & 31, h = lane >> 5;
    LAS unsigned char* kst = lds + ATT_KST_OFF;
    LAS float* sc0 = (LAS float*)(lds + wave * 16384); LAS float* sc1 = sc0 + 2048;
    const int srow = tid >> 3, sch = tid & 7, slo = srow * 128 + ((sch ^ ((srow >> 1) & 7)) * 16);
    { const u32x4 v = *(const u32x4*)(KIDXb + (size_t)srow * 64 + sch * 8); *(LAS u32x4*)(kst + slo) = v; }
    bf16x8 aq[2][4]; float wv[2][16];
#pragma unroll
    for (int ct = 0; ct < 2; ++ct) { const bf16_t* pr = PROJ + (size_t)(mb0 + ct) * LDP;
#pragma unroll
        for (int s2 = 0; s2 < 4; ++s2) aq[ct][s2] = *(const bf16x8*)(pr + C_QIDX + r * 64 + 16 * s2 + 8 * h);
#pragma unroll
        for (int i = 0; i < 16; ++i) wv[ct][i] = bf2f(pr[C_WIDX + crow(i, h)]) * 0.17677669529663687f; }
    const int pos_t0 = posb[t_0], pos_t1 = posb[t_0 + 1];
    u32x4 p1 = (u32x4){0u, 0u, 0u, 0u};
    if (njp > 1) p1 = *(const u32x4*)(KIDXb + (size_t)(64 + srow) * 64 + sch * 8);
    int pk_cur = posb[lane];
    __syncthreads();
    for (int jp = 0; jp < njp; ++jp) {
        const bool pre = (jp + 1 < njp);
        u32x4 p2 = (u32x4){0u, 0u, 0u, 0u}; int pk_nxt = 0;
        if (jp + 2 < njp) p2 = *(const u32x4*)(KIDXb + (size_t)(64 * (jp + 2) + srow) * 64 + sch * 8);
        if (pre) pk_nxt = posb[64 * (jp + 1) + lane];
        const LAS unsigned char* kb = kst + (jp & 1) * 8192;
        float tot[2][2];
#pragma unroll
        for (int hh = 0; hh < 2; ++hh) {
            const int rowl = 32 * hh + r; const LAS unsigned char* rb = kb + rowl * 128; const int sw = (rowl >> 1) & 7;
            bf16x8 bk[4];
#pragma unroll
            for (int s2 = 0; s2 < 4; ++s2) bk[s2] = *(const LAS bf16x8*)(rb + (((2 * s2 + h) ^ sw) * 16));
#pragma unroll
            for (int ct = 0; ct < 2; ++ct) {
                f32x16 acc;
#pragma unroll
                for (int i = 0; i < 16; ++i) acc[i] = 0.f;
#pragma unroll
                for (int s2 = 0; s2 < 4; ++s2) acc = __builtin_amdgcn_mfma_f32_32x32x16_bf16(aq[ct][s2], bk[s2], acc, 0, 0, 0);
                float p = 0.f;
#pragma unroll
                for (int i = 0; i < 16; ++i) p += wv[ct][i] * __builtin_amdgcn_fmed3f(acc[i], 0.f, __builtin_inff());
                p += __shfl_xor(p, 32);
                tot[ct][hh] = p;
            }
        }
        const int key = 64 * jp + lane; const int pk = pk_cur;
        sc0[key] = (pk <= pos_t0) ? (h ? tot[0][1] : tot[0][0]) : -INFINITY;
        sc1[key] = (pk <= pos_t1) ? (h ? tot[1][1] : tot[1][0]) : -INFINITY;
        if (pre) *(LAS u32x4*)(kst + ((jp + 1) & 1) * 8192 + slo) = p1;
        p1 = p2; pk_cur = pk_nxt;
        asm volatile("s_waitcnt lgkmcnt(0)" ::: "memory"); __builtin_amdgcn_s_barrier(); asm volatile("" ::: "memory");
    }
    {
        unsigned ua[32], ub[32]; int na = 0, nb2 = 0;
#pragma unroll
        for (int i = 0; i < 32; ++i) { float fa = -INFINITY, fb = -INFINITY; if (i < njp) { fa = sc0[64 * i + lane]; fb = sc1[64 * i + lane]; }
            const unsigned ba = __float_as_uint(fa), bb = __float_as_uint(fb);
            ua[i] = ba ^ ((ba >> 31) ? 0xFFFFFFFFu : 0x80000000u); ub[i] = bb ^ ((bb >> 31) ? 0xFFFFFFFFu : 0x80000000u);
            na += (ua[i] != 0x007FFFFFu) ? 1 : 0; nb2 += (ub[i] != 0x007FFFFFu) ? 1 : 0; }
        auto wave_total2 = [&](int ca, int cb, int& ta, int& tb) __attribute__((always_inline)) {
            int x = ca | (cb << 16);
            x += __builtin_amdgcn_update_dpp(0, x, 0xB1, 0xF, 0xF, true); x += __builtin_amdgcn_update_dpp(0, x, 0x4E, 0xF, 0xF, true);
            x += __builtin_amdgcn_update_dpp(0, x, 0x141, 0xF, 0xF, true); x += __builtin_amdgcn_update_dpp(0, x, 0x140, 0xF, 0xF, true);
            const int t = __builtin_amdgcn_readlane(x, 0) + __builtin_amdgcn_readlane(x, 16) + __builtin_amdgcn_readlane(x, 32) + __builtin_amdgcn_readlane(x, 48);
            ta = t & 0xFFFF; tb = (t >> 16) & 0xFFFF; };
        int ta, tb; wave_total2(na, nb2, ta, tb);
        unsigned Ta = 0x00800000u, Tb = 0x00800000u;
        bool ra = ta > 256, rb = tb > 256;
        if (ra) Ta = 0u; if (rb) Tb = 0u;
#pragma unroll 1
        for (int bit = 31; bit >= 0 && (ra || rb); --bit) {
            const unsigned ca = Ta | (1u << bit), cb = Tb | (1u << bit); int cnta = 0, cntb = 0;
#pragma unroll
            for (int i = 0; i < 32; ++i) { cnta += (ua[i] >= ca) ? 1 : 0; cntb += (ub[i] >= cb) ? 1 : 0; }
            int wa_, wb_; wave_total2(cnta, cntb, wa_, wb_);
            if (ra) { if (wa_ >= 256) Ta = ca; if (wa_ == 256) ra = false; }
            if (rb) { if (wb_ >= 256) Tb = cb; if (wb_ == 256) rb = false; }
        }
#pragma unroll
        for (int i = 0; i < 32; ++i) { const unsigned long long wa = __ballot(ua[i] >= Ta), wb = __ballot(ub[i] >= Tb); if (lane == 0) { smask_w[i] = wa; smask_w[32 + i] = wb; } }
    }
}

template <bool DOA, bool DOB>
DI void p4_attention(const Args& a, LAS unsigned char* lds, int G) {
    const int tid = threadIdx.x, lane = tid & 63, wave = __builtin_amdgcn_readfirstlane(tid >> 6);
    const bf16_t* PROJ = (const bf16_t*)(a.ws + WS_PROJ);
    const bf16_t* QA = (const bf16_t*)((const unsigned char*)a.out + DO_QA); const bf16_t* KA = (const bf16_t*)((const unsigned char*)a.out + DO_KA); const bf16_t* VAT = (const bf16_t*)((const unsigned char*)a.out + DO_VAT);
    const bf16_t* QB = (const bf16_t*)(a.ws + WS_QB); const bf16_t* KBn = (const bf16_t*)(a.ws + WS_KB); const bf16_t* VBT = (const bf16_t*)(a.ws + WS_VBT); const bf16_t* KIDX = (const bf16_t*)(a.ws + WS_KIDX);
    bf16_t* OCAT = (bf16_t*)(a.ws + WS_HN);
    LAS float* tb = (LAS float*)(lds + ATT_TB_OFF);
    LAS unsigned long long* smask = (LAS unsigned long long*)(lds + ATT_MASK_OFF);
    if (DOB) for (int e = tid; e < 129 * 16; e += NTHREADS) { const int d = e >> 4, hd = e & 15; int bk;
        if (d < 16) bk = d; else { bk = 16 + (int)(logf((float)d / 16.f) / 2.0794415416798357f * 16.f); bk = bk < 31 ? bk : 31; }
        tb[e] = a.t5[bk * 16 + hd] * LOG2E; }
    __syncthreads();
    f32x4 o[2][8]; float lsum[2];
    if (DOA) for (int it = blockIdx.x; it < 256; it += G) {
        const int xq = it & 7, yq = it >> 3, gq = yq >> 2, pq = yq & 3;
        for (int j = 0; j < 4; ++j) {
            const int combo = xq * 16 + 2 * gq + (j >> 1), b = combo >> 4, hd = combo & 15;
            const bf16_t* Kg = KA + (size_t)(b * 16 + hd) * L * 192; const bf16_t* Vtg = VAT + (size_t)(b * 16 + hd) * 128 * L; const bf16_t* Qg = QA + (size_t)(b * 16 + hd) * L * 192;
            const int qb = (j & 1) ? pq : 7 - pq;
            int lo_ = lane; asm volatile("" : "+v"(lo_)); const int r = lo_ & 15, q = lo_ >> 4;
            const int q0 = qb * 256, qi0 = q0 + 32 * wave + r, qi1 = qi0 + 16;
            attn_core<192, false>(lds, Kg, Vtg, Qg + (size_t)qi0 * 192, Qg + (size_t)qi1 * 192, 4 * (qb + 1), qi0, qi1, q0 + 32 * wave + 31, nullptr, nullptr, nullptr, nullptr, 0, 0, o, lsum);
#pragma unroll
            for (int ct = 0; ct < 2; ++ct) { const float inv = __builtin_amdgcn_rcpf(lsum[ct]); const size_t m = (size_t)b * L + (ct ? qi1 : qi0);
                const bf16_t* gp = PROJ + m * LDP + C_GA + hd * 128 + 4 * q; bf16_t* op = OCAT + m * 4096 + hd * 128 + 4 * q;
#pragma unroll
                for (int dt = 0; dt < 8; ++dt) { const u32x2 g = *(const u32x2*)(gp + 16 * dt); const f32x4 v = o[ct][dt] * inv;
                    u32x2 w; w.x = pk2(v[0] * silu(lo16(g.x)), v[1] * silu(hi16(g.x))); w.y = pk2(v[2] * silu(lo16(g.y)), v[3] * silu(hi16(g.y)));
                    *(u32x2*)(op + 16 * dt) = w; } }
        }
    }
    if (DOB) for (int it = blockIdx.x; it < 256; it += G) {
        const int b = it & 7, jx = it >> 3;
        const int* posb = a.pos + (size_t)b * L; const bf16_t* KIDXb = KIDX + (size_t)b * L * 64;
        const bf16_t* Kg = KBn + (size_t)b * L * 128; const bf16_t* Vtg = VBT + (size_t)b * 128 * L;
        for (int j = 0; j < 4; ++j) {
            const int un = (j == 0) ? jx : (j == 1) ? 63 - jx : (j == 2) ? 64 + jx : 127 - jx;
            int lo_ = lane; asm volatile("" : "+v"(lo_)); const int r = lo_ & 15, q = lo_ >> 4;
            const int t0 = un * 16, t_0 = t0 + 2 * wave, t_1 = t_0 + 1;
            indexer_unit(lds, smask + wave * 64, PROJ, KIDXb, posb, b * L + t_0, t_0, ((t0 + 15) >> 6) + 1, wave, lane);
            __syncthreads();
            const bf16_t* qp0 = QB + ((size_t)(b * L + t_0) * 16 + r) * 128; const bf16_t* qp1 = QB + ((size_t)(b * L + t_1) * 16 + r) * 128;
            attn_core<128, true>(lds, Kg, Vtg, qp0, qp1, (t0 + 79) >> 6, 0, 0, 0, smask + (wave * 2 + 0) * 32, smask + (wave * 2 + 1) * 32, tb, posb, posb[t_0], posb[t_1], o, lsum);
#pragma unroll
            for (int ct = 0; ct < 2; ++ct) { const float inv = __builtin_amdgcn_rcpf(lsum[ct]); const size_t m = (size_t)b * L + (ct ? t_1 : t_0);
                const bf16_t* gp = PROJ + m * LDP + C_GB + r * 128 + 4 * q; bf16_t* op = OCAT + m * 4096 + 2048 + r * 128 + 4 * q;
#pragma unroll
                for (int dt = 0; dt < 8; ++dt) { const u32x2 g = *(const u32x2*)(gp + 16 * dt); const f32x4 v = o[ct][dt] * inv;
                    u32x2 w; w.x = pk2(v[0] * silu(lo16(g.x)), v[1] * silu(hi16(g.x))); w.y = pk2(v[2] * silu(lo16(g.y)), v[3] * silu(hi16(g.y)));
                    *(u32x2*)(op + 16 * dt) = w; } }
        }
    }
}

__global__ void __launch_bounds__(NTHREADS, 2) fwd_megakernel(Args a) {
    extern __shared__ __attribute__((aligned(16))) unsigned char lds_raw[];
    LAS unsigned char* lds = (LAS unsigned char*)lds_raw;
    const int G = gridDim.x, lo = a.ph_lo, hi = a.ph_hi;
#define IN(k) (lo <= (k) && (k) < hi)
#if MK_MULTI
#define GSYNC(k) do { } while (0)
#else
    cg::grid_group grid = cg::this_grid();
    volatile LAS unsigned* bst = (volatile LAS unsigned*)(lds + LDS_BYTES - 16);
    if (threadIdx.x < 4) bst[threadIdx.x] = 0u;
    __syncthreads();
    XcdBarrier xbar = xcd_barrier_post((unsigned*)(a.ws + WS_BAR), bst);
    if (a.ph_hi > 1000) grid.sync();
#define GSYNC(k) do { if (IN(k) && IN((k) + 1)) xcd_barrier(xbar); } while (0)
#endif
    bf16_t* PROJ = (bf16_t*)(a.ws + WS_PROJ);
    if (IN(0)) p0_prologue(a, lds, G);
    GSYNC(0);
    if (IN(1)) {
        pg8::Gemm g{(const bf16_t*)(a.ws + WS_HN), (const bf16_t*)(a.ws + WS_WIN_T), M, LDP, DM, DM, DM}; pg8::StaticOrder S; S.init(M, LDP, G, (int)blockIdx.x);
        pg8::EpiBf16 E{PROJ, LDP};
        pg8::gemm_phase<pg8::EpiBf16>(lds, g, S, E);
    }
    GSYNC(1);
    if (IN(2)) {
        { pg8::Gemm g{PROJ + C_CQ, (const bf16_t*)(a.ws + WS_WUQ_T), M, 3072, 1024, LDP, 1024}; pg8::StaticOrder S; S.init(M, 3072, G, (int)blockIdx.x);
          pg8::EpiBf16 E{(bf16_t*)(a.ws + WS_WIN_T), 3072}; pg8::gemm_phase<pg8::EpiBf16>(lds, g, S, E); }
        { pg8::Gemm g{PROJ + C_CKV, (const bf16_t*)(a.ws + WS_WUKV_T), M, 4096, 512, LDP, 512}; pg8::StaticOrder S; S.init(M, 4096, G, (int)blockIdx.x);
          pg8::EpiBf16 E{(bf16_t*)(a.ws + WS_HN), 4096}; pg8::gemm_phase<pg8::EpiBf16>(lds, g, S, E); }
    }
    GSYNC(2);
    if (IN(3)) p3_prep(a, lds, G);
    GSYNC(3);
    if (IN(4)) p4_attention<true, false>(a, lds, G);
    if (IN(5)) p4_attention<false, true>(a, lds, G);
    GSYNC(5);
    if (IN(6)) {
        pg8::Gemm g{(const bf16_t*)(a.ws + WS_HN), (const bf16_t*)(a.ws + WS_PCAT_T), M, 4096, 4096, 4096, 4096}; pg8::StaticOrder S; S.init(M, 4096, G, (int)blockIdx.x);
        pg8::EpiMerge E{(bf16_t*)(a.ws + WS_WIN_T), 4096, PROJ};
        pg8::gemm_phase<pg8::EpiMerge>(lds, g, S, E);
    }
    GSYNC(6);
    if (IN(7)) {
        pg8::Gemm g{(const bf16_t*)(a.ws + WS_WIN_T), (const bf16_t*)(a.ws + WS_WO_T), M, 4096, 4096, 4096, 4096}; pg8::StaticOrder S; S.init(M, 4096, G, (int)blockIdx.x);
        pg8::EpiResid E{a.x, a.out, 4096};
        pg8::gemm_phase<pg8::EpiResid>(lds, g, S, E);
    }
#undef IN
#undef GSYNC
}

extern "C" void kernel_launch(void* const* d_in, const int* in_sizes, int n_in, void* d_out, int out_size, void* d_ws, size_t ws_size, hipStream_t stream) {
    static int grid = 0;
    if (grid == 0) {
        if (n_in != 16 || out_size != M * DM || ws_size < WS_END) { fprintf(stderr, "kernel_launch: unexpected shapes (n_in %d, out %d, ws %zu)\n", n_in, out_size, ws_size); grid = -1; return; }
        int dev = 0, cus = 0, per_cu = 0;
        hipGetDevice(&dev); hipDeviceGetAttribute(&cus, hipDeviceAttributeMultiprocessorCount, dev);
        if (hipFuncSetAttribute((const void*)fwd_megakernel, hipFuncAttributeMaxDynamicSharedMemorySize, LDS_BYTES) != hipSuccess) { fprintf(stderr, "kernel_launch: hipFuncSetAttribute failed\n"); grid = -1; return; }
        if (hipOccupancyMaxActiveBlocksPerMultiprocessor(&per_cu, (const void*)fwd_megakernel, NTHREADS, LDS_BYTES) != hipSuccess || per_cu < 1) per_cu = 1;
        (void)hipGetLastError();
        grid = cus * per_cu;
        if (grid <= 0) grid = 256;
    }
    if (grid < 0) return;
    Args a{};
    a.x = (const float*)d_in[0]; a.pos = (const int*)d_in[1]; a.g_pre = (const float*)d_in[2]; a.w_in = (const float*)d_in[3]; a.g_q_lat = (const float*)d_in[4]; a.g_kv_lat = (const float*)d_in[5];
    a.w_uq = (const float*)d_in[6]; a.w_ukv = (const float*)d_in[7]; a.g_qn_a = (const float*)d_in[8]; a.g_kn_a = (const float*)d_in[9]; a.g_qn_b = (const float*)d_in[10]; a.g_kn_b = (const float*)d_in[11];
    a.t5 = (const float*)d_in[12]; a.p_a = (const float*)d_in[13]; a.p_b = (const float*)d_in[14]; a.w_o = (const float*)d_in[15];
    a.out = (float*)d_out; a.ws = (unsigned char*)d_ws;
#if MK_MULTI
    for (int ph = 0; ph < 8; ++ph) { a.ph_lo = ph; a.ph_hi = ph + 1; for (int rep = 0; rep < (ph == (MK_DUP) ? 2 : 1); ++rep) hipLaunchKernelGGL(fwd_megakernel, dim3(grid), dim3(NTHREADS), LDS_BYTES, stream, a); }
#else
    a.ph_lo = 0; a.ph_hi = 8;
    if (hipMemsetAsync((unsigned char*)d_ws + WS_BAR, 0, 16384, stream) != hipSuccess) { fprintf(stderr, "kernel_launch: memset of the barrier words failed\n"); return; }
    void* args[] = {&a};
    hipError_t e = hipLaunchCooperativeKernel((const void*)fwd_megakernel, dim3(grid), dim3(NTHREADS), args, LDS_BYTES, stream);
    if (e != hipSuccess) fprintf(stderr, "cooperative launch failed: %s (grid %d)\n", hipGetErrorString(e), grid);
#endif
}
```

```cpp
#include <hip/hip_runtime.h>
#include <hip/hip_cooperative_groups.h>
#include <cstdio>
#include <cstdint>
namespace cg = cooperative_groups;

#ifndef MK_MULTI
#define MK_MULTI 0
#endif

#ifndef MK_DUP
#define MK_DUP -1
#endif
#define LAS __attribute__((address_space(3)))
#define DI __device__ __forceinline__
typedef unsigned short bf16_t;
typedef short bf16x8 __attribute__((ext_vector_type(8)));
typedef short s16x4 __attribute__((ext_vector_type(4)));
typedef float f32x4 __attribute__((ext_vector_type(4)));
typedef float f32x16 __attribute__((ext_vector_type(16)));
typedef unsigned u32x4 __attribute__((ext_vector_type(4)));
typedef unsigned u32x2 __attribute__((ext_vector_type(2)));
typedef int i32x4 __attribute__((ext_vector_type(4)));
typedef __bf16 bf16v2 __attribute__((ext_vector_type(2)));
typedef float f32v2 __attribute__((ext_vector_type(2)));

constexpr int DM = 4096, NBATCH = 8, L = 2048, M = NBATCH * L;
constexpr int LDP = 18432, NCOLS = 18336;
constexpr int C_CQ = 0, C_CKV = 1024, C_KROPE = 1536, C_QB = 1600, C_KB = 3648, C_VB = 3776, C_QIDX = 3904, C_KIDX = 5952, C_WIDX = 6016,
              C_GA = 6048, C_GB = 8096, C_MA = 10144, C_MB = 14240;
constexpr float EPS = 1e-6f;
constexpr float LOG2E = 1.4426950408889634f;
constexpr float QSA = 0.07216878364870322f * LOG2E;
constexpr float QSB = 0.08838834764831845f * LOG2E;
constexpr int NTHREADS = 512, NWAVES = 8;
constexpr int LDS_BYTES = 160256;

constexpr size_t WS_WIN_T = 0;
constexpr size_t WS_HN    = 150994944;
constexpr size_t WS_PROJ  = 285212672;
constexpr size_t WS_QB    = 889192448;
constexpr size_t WS_WUQ_T = 956301312;
constexpr size_t WS_WUKV_T= 962592768;
constexpr size_t WS_PCAT_T= 966787072;
constexpr size_t WS_WO_T  = 1000341504;
constexpr size_t WS_KB    = 1033895936;
constexpr size_t WS_VBT   = 1038090240;
constexpr size_t WS_KIDX  = 1042284544;
constexpr size_t WS_BAR   = 1044381696;
constexpr size_t WS_END   = WS_BAR + 16384;
constexpr size_t DO_QA = 0, DO_KA = 100663296, DO_VAT = 201326592;

DI float bf2f(unsigned v) { return __uint_as_float(v << 16); }
DI unsigned pk2(float lo, float hi) { f32v2 v = {lo, hi}; bf16v2 b = __builtin_convertvector(v, bf16v2); return __builtin_bit_cast(unsigned, b); }
DI float lo16(unsigned w) { return __uint_as_float(w << 16); }
DI float hi16(unsigned w) { return __uint_as_float(w & 0xffff0000u); }
template <int CTRL> DI float dpp_mov(float v) { return __builtin_bit_cast(float, __builtin_amdgcn_update_dpp(0, __builtin_bit_cast(int, v), CTRL, 0xF, 0xF, true)); }
DI float row_sum(float v) {
    v += dpp_mov<0xB1>(v); v += dpp_mov<0x4E>(v); v += dpp_mov<0x141>(v); v += dpp_mov<0x140>(v);
    return v;
}
DI float half_sum(float v) { v = row_sum(v); v += __shfl_xor(v, 16); return v; }
DI float wave_sum(float v) { v = half_sum(v); v += __shfl_xor(v, 32); return v; }
DI float sumsq8(u32x4 a) {
    float s = 0.f;
#pragma unroll
    for (int i = 0; i < 4; ++i) { const float x = lo16(a[i]), y = hi16(a[i]); s += x * x + y * y; }
    return s;
}

namespace pg8 {
constexpr int BM = 256, BK = 64, HALF = 128, HTB = HALF * BK * 2, STAGE_BYTES = 8 * HTB, NXCD = 8, WGM = 8;
__host__ __device__ __forceinline__ int lds_byte(int r, int c) { const int st = (r >> 4) * 2 + (c >> 5), rr = r & 15, cc = c & 31, ob = rr * 64 + cc * 2; return st * 1024 + (ob ^ (((ob >> 9) & 1) << 5)); }
__host__ __device__ __forceinline__ void stage_rc(int b, int& R, int& C) { const int st = b / 1024, sb = b % 1024, swz = sb ^ (((sb >> 9) & 1) << 5); R = (st >> 1) * 16 + swz / 64; C = (st & 1) * 32 + (swz % 64) / 2; }
__host__ __device__ __forceinline__ int perm32(int rho) { const int n = rho >> 4, i = rho & 15; return 8 * (i >> 2) + 4 * n + (i & 3); }
struct Unit { int pm, pn; };
struct Gemm { const bf16_t* A; const bf16_t* Bt; int M, N, K, lda, ldb; };
struct StaticOrder {
    int nM, nN, nwg, G, c;
    __device__ void init(int M_, int N_, int G_, int c_) { nM = M_ / BM; nN = N_ / BM; nwg = nM * nN; G = G_; c = c_; }
    __device__ bool next(int i, Unit& u) const {
        const long Lx = (long)i * G + c; if (Lx >= nwg) return false;
        int wgid = (int)Lx; { const int q = nwg / NXCD, r = nwg % NXCD, xcd = wgid % NXCD, off = wgid / NXCD; wgid = (xcd < r ? xcd * (q + 1) : r * (q + 1) + (xcd - r) * q) + off; }
        const int nig = WGM * nN, gid = wgid / nig, fm = gid * WGM, gsz = (nM - fm) < WGM ? (nM - fm) : WGM;
        u.pm = fm + ((wgid % nig) % gsz); u.pn = (wgid % nig) / gsz; return true;
    }
};
struct EpiBf16 {
    static constexpr bool PERM = true, MID = false;
    bf16_t* O; int ldc;
    DI void mid(f32x4 (&)[2][2][4][2], const Unit&, int, int, int, int) const {}
    DI void operator()(const f32x4 (&acc)[2][2][4][2], const Unit& u, int wr, int wc, int fr, int fq) const {
        const int row0 = u.pm * BM + wr * 64 + fr, col0 = u.pn * BM + wc * 32 + 8 * fq;
#pragma unroll
        for (int ai = 0; ai < 2; ++ai)
#pragma unroll
            for (int m = 0; m < 4; ++m) { bf16_t* rowp = O + (size_t)(row0 + ai * HALF + m * 16) * ldc + col0;
#pragma unroll
                for (int bj = 0; bj < 2; ++bj) { const f32x4 v0 = acc[ai][bj][m][0], v1 = acc[ai][bj][m][1];
                    u32x4 w; w.x = pk2(v0[0], v0[1]); w.y = pk2(v0[2], v0[3]); w.z = pk2(v1[0], v1[1]); w.w = pk2(v1[2], v1[3]);
                    *(u32x4*)(rowp + bj * HALF) = w; } }
    }
};
DI float clampm(float x) { return fminf(fmaxf(x, -30.f), 30.f); }
struct EpiMerge {
    static constexpr bool PERM = true, MID = true;
    bf16_t* O; int ldc; const bf16_t* proj;
    DI void mid(f32x4 (&acc)[2][2][4][2], const Unit& u, int wr, int wc, int fr_in, int fq) const {
        int fr = fr_in; asm volatile("" : "+v"(fr));
        const int row0 = u.pm * BM + wr * 64 + fr, col0 = u.pn * BM + wc * 32 + 8 * fq;
#pragma unroll
        for (int ai = 0; ai < 2; ++ai) {
            u32x4 ga[4][2], gb[4][2];
#pragma unroll
            for (int m = 0; m < 4; ++m) { const bf16_t* pr = proj + (size_t)(row0 + ai * HALF + m * 16) * LDP + col0;
#pragma unroll
                for (int bj = 0; bj < 2; ++bj) { ga[m][bj] = *(const u32x4*)(pr + C_MA + bj * HALF); gb[m][bj] = *(const u32x4*)(pr + C_MB + bj * HALF); } }
#pragma unroll
            for (int m = 0; m < 4; ++m)
#pragma unroll
                for (int bj = 0; bj < 2; ++bj)
#pragma unroll
                    for (int i = 0; i < 4; ++i) {
                        const float ma0 = clampm(lo16(ga[m][bj][i])), ma1 = clampm(hi16(ga[m][bj][i])), mb0 = clampm(lo16(gb[m][bj][i])), mb1 = clampm(hi16(gb[m][bj][i]));
                        const float r0 = (1.f + __expf(-mb0)) * __builtin_amdgcn_rcpf(1.f + __expf(-ma0)), r1 = (1.f + __expf(-mb1)) * __builtin_amdgcn_rcpf(1.f + __expf(-ma1));
                        acc[ai][bj][m][i >> 1][(i & 1) * 2] *= r0; acc[ai][bj][m][i >> 1][(i & 1) * 2 + 1] *= r1; }
            asm volatile("" ::: "memory"); }
    }
    DI void operator()(const f32x4 (&acc)[2][2][4][2], const Unit& u, int wr, int wc, int fr, int fq) const {
        const int row0 = u.pm * BM + wr * 64 + fr, col0 = u.pn * BM + wc * 32 + 8 * fq;
        u32x4 gb[2][4][2];
#pragma unroll
        for (int ai = 0; ai < 2; ++ai)
#pragma unroll
            for (int m = 0; m < 4; ++m) { const bf16_t* pr = proj + (size_t)(row0 + ai * HALF + m * 16) * LDP + col0;
#pragma unroll
                for (int bj = 0; bj < 2; ++bj) gb[ai][m][bj] = *(const u32x4*)(pr + C_MB + bj * HALF); }
#pragma unroll
        for (int ai = 0; ai < 2; ++ai)
#pragma unroll
            for (int m = 0; m < 4; ++m) { bf16_t* rowp = O + (size_t)(row0 + ai * HALF + m * 16) * ldc + col0;
#pragma unroll
                for (int bj = 0; bj < 2; ++bj) { float o[8];
#pragma unroll
                    for (int i = 0; i < 4; ++i) { const float mb0 = clampm(lo16(gb[ai][m][bj][i])), mb1 = clampm(hi16(gb[ai][m][bj][i]));
                        o[2 * i] = acc[ai][bj][m][i >> 1][(i & 1) * 2] * __builtin_amdgcn_rcpf(1.f + __expf(-mb0)); o[2 * i + 1] = acc[ai][bj][m][i >> 1][(i & 1) * 2 + 1] * __builtin_amdgcn_rcpf(1.f + __expf(-mb1)); }
                    u32x4 w; w.x = pk2(o[0], o[1]); w.y = pk2(o[2], o[3]); w.z = pk2(o[4], o[5]); w.w = pk2(o[6], o[7]);
                    *(u32x4*)(rowp + bj * HALF) = w; } }
    }
};
struct EpiResid {
    static constexpr bool PERM = false, MID = false;
    const float* base; float* out; int ldc;
    DI void mid(f32x4 (&)[2][2][4][2], const Unit&, int, int, int, int) const {}
    DI void operator()(const f32x4 (&acc)[2][2][4][2], const Unit& u, int wr, int wc, int fr, int fq) const {
        const int row0 = u.pm * BM + wr * 64 + fr, col0 = u.pn * BM + wc * 32 + 4 * fq;
#pragma unroll
        for (int ai = 0; ai < 2; ++ai) {
            f32x4 bs[4][2][2];
#pragma unroll
            for (int m = 0; m < 4; ++m) { const size_t off = (size_t)(row0 + ai * HALF + m * 16) * ldc + col0;
#pragma unroll
                for (int bj = 0; bj < 2; ++bj)
#pragma unroll
                    for (int n = 0; n < 2; ++n) bs[m][bj][n] = *(const f32x4*)(base + off + bj * HALF + n * 16); }
#pragma unroll
            for (int m = 0; m < 4; ++m) { const size_t off = (size_t)(row0 + ai * HALF + m * 16) * ldc + col0;
#pragma unroll
                for (int bj = 0; bj < 2; ++bj)
#pragma unroll
                    for (int n = 0; n < 2; ++n) *(f32x4*)(out + off + bj * HALF + n * 16) = bs[m][bj][n] + acc[ai][bj][m][n]; }
            asm volatile("" ::: "memory"); }
    }
};

template <class Epi, bool ALIGN_EPI = true, bool SP2 = true>
DI void gemm_phase(LAS unsigned char* lds, const Gemm g, const StaticOrder& S, const Epi& E) {
    const int tid = threadIdx.x, wid = __builtin_amdgcn_readfirstlane(tid >> 6), lane = tid & 63, wr = wid >> 2, wc = wid & 3, fr = lane & 15, fq = lane >> 4;
    const int K = g.K, nt = K / BK;
    unsigned voffA[2], voffB[2];
#pragma unroll
    for (int i = 0; i < 2; ++i) { int R, C; stage_rc(tid * 16 + i * 8192, R, C); const int Rb = Epi::PERM ? ((R & ~31) + perm32(R & 31)) : R;
        voffA[i] = (unsigned)(R * g.lda + C) * 2u; voffB[i] = (unsigned)(Rb * g.ldb + C) * 2u; }
    const size_t kstep = (size_t)(BK * 2);
    const size_t hstepA = (size_t)HALF * g.lda * 2, hstepB = (size_t)HALF * g.ldb * 2;
    const size_t tstepA = 2 * hstepA, tstepB = 2 * hstepB;
    const unsigned ldsw = (unsigned)wid * 1024u;
    const int aoff = lds_byte(wr * 64 + fr, fq * 8), boff = lds_byte(wc * 32 + fr, fq * 8);
#define PG8_SA(b, h) (((b) * 2 + (h)) * HTB)
#define PG8_SB(b, h) ((4 + (b) * 2 + (h)) * HTB)
#define PG8_STAGE(bufoff, gbase, voff) do { _Pragma("unroll") for (int _i = 0; _i < 2; ++_i) \
        __builtin_amdgcn_global_load_lds((const unsigned*)((const char*)(gbase) + (voff)[_i]), (LAS unsigned*)(lds + (bufoff) + ldsw + _i * 8192), 16, 0, 0); } while (0)
#define PG8_LDA(dst, b, h) do { _Pragma("unroll") for (int m = 0; m < 4; ++m) _Pragma("unroll") for (int k = 0; k < 2; ++k) dst[m][k] = *(const LAS bf16x8*)(lds + PG8_SA(b, h) + aoff + m * 2048 + k * 1024); } while (0)
#define PG8_LDB(dst, b, h) do { _Pragma("unroll") for (int n = 0; n < 2; ++n) _Pragma("unroll") for (int k = 0; k < 2; ++k) dst[n][k] = *(const LAS bf16x8*)(lds + PG8_SB(b, h) + boff + n * 2048 + k * 1024); } while (0)
#define PG8_MMA(ai, bj, At, Bt) do { __builtin_amdgcn_s_setprio(1); _Pragma("unroll") for (int m = 0; m < 4; ++m) _Pragma("unroll") for (int n = 0; n < 2; ++n) _Pragma("unroll") for (int k = 0; k < 2; ++k) \
        acc[ai][bj][m][n] = __builtin_amdgcn_mfma_f32_16x16x32_bf16(Bt[n][k], At[m][k], acc[ai][bj][m][n], 0, 0, 0); __builtin_amdgcn_s_setprio(0); } while (0)
#define PG8_WAIT_V(n) asm volatile("s_waitcnt vmcnt(" #n ")" ::: "memory")
#define PG8_WAIT_L(n) asm volatile("s_waitcnt lgkmcnt(" #n ")" ::: "memory")
#define PG8_BAR __builtin_amdgcn_s_barrier()
#define PG8_SCHED __builtin_amdgcn_sched_barrier(0)
    Unit cur, nxt; int ui = 0;
    if (!S.next(0, cur)) return;
    f32x4 acc[2][2][4][2];
#pragma unroll
    for (int a = 0; a < 2; ++a)
#pragma unroll
        for (int b = 0; b < 2; ++b)
#pragma unroll
            for (int m = 0; m < 4; ++m)
#pragma unroll
                for (int n = 0; n < 2; ++n) acc[a][b][m][n] = (f32x4){0.f, 0.f, 0.f, 0.f};
    bf16x8 At[4][2], B0[2][2], B1[2][2];
    const char* cA = (const char*)g.A + (size_t)cur.pm * tstepA; const char* cB = (const char*)g.Bt + (size_t)cur.pn * tstepB;
    if constexpr (SP2) {
        PG8_STAGE(PG8_SB(0, 0), cB, voffB); PG8_STAGE(PG8_SB(0, 1), cB + hstepB, voffB); PG8_STAGE(PG8_SA(0, 0), cA, voffA); PG8_STAGE(PG8_SA(0, 1), cA + hstepA, voffA);
        if (wr == 1) PG8_BAR;
        PG8_WAIT_V(2); PG8_BAR;
        PG8_STAGE(PG8_SB(1, 0), cB + kstep, voffB); PG8_STAGE(PG8_SA(1, 0), cA + kstep, voffA); PG8_STAGE(PG8_SB(1, 1), cB + hstepB + kstep, voffB);
        PG8_WAIT_V(6); PG8_BAR;
    } else {
    PG8_STAGE(PG8_SB(0, 0), cB, voffB); PG8_STAGE(PG8_SA(0, 0), cA, voffA); PG8_STAGE(PG8_SB(0, 1), cB + hstepB, voffB); PG8_STAGE(PG8_SA(0, 1), cA + hstepA, voffA);
    if (wr == 1) PG8_BAR;
    PG8_WAIT_V(4); PG8_BAR;
    PG8_STAGE(PG8_SB(1, 0), cB + kstep, voffB); PG8_STAGE(PG8_SA(1, 0), cA + kstep, voffA); PG8_STAGE(PG8_SB(1, 1), cB + hstepB + kstep, voffB);
    PG8_WAIT_V(6); PG8_BAR;
    }
    for (;;) {
        const bool has_next = S.next(ui + 1, nxt);
        const char* nA = has_next ? (const char*)g.A + (size_t)nxt.pm * tstepA : cA; const char* nB = has_next ? (const char*)g.Bt + (size_t)nxt.pn * tstepB : cB;
        for (int t = 0; t < nt; t += 2) {
            const bool last = (t == nt - 2);
            const char* a1 = cA + (size_t)(t + 1) * kstep;
            const char* a2 = last ? nA : cA + (size_t)(t + 2) * kstep; const char* b2 = last ? nB : cB + (size_t)(t + 2) * kstep;
            const char* a3 = a2 + kstep; const char* b3 = b2 + kstep;
            if (Epi::MID) { if (t == (nt >> 1)) {
                if constexpr (ALIGN_EPI) { if (wr == 0) PG8_BAR; }
                E.mid(acc, cur, wr, wc, fr, fq);
                if constexpr (ALIGN_EPI) { if (wr == 1) PG8_BAR; } } }
            if constexpr (SP2) {
            PG8_LDB(B0, 0, 0); PG8_LDB(B1, 0, 1); PG8_SCHED; PG8_LDA(At, 0, 0); PG8_STAGE(PG8_SA(1, 1), a1 + hstepA, voffA);
            PG8_WAIT_V(8); PG8_WAIT_L(0); PG8_BAR; PG8_MMA(0, 0, At, B0); PG8_MMA(0, 1, At, B1); PG8_BAR; PG8_SCHED;
            PG8_LDA(At, 0, 1); PG8_STAGE(PG8_SB(0, 0), b2, voffB); PG8_STAGE(PG8_SB(0, 1), b2 + hstepB, voffB); PG8_STAGE(PG8_SA(0, 0), a2, voffA);
            PG8_WAIT_V(8); PG8_WAIT_L(0); PG8_BAR; PG8_MMA(1, 0, At, B0); PG8_MMA(1, 1, At, B1); PG8_BAR; PG8_SCHED;
            PG8_LDB(B0, 1, 0); PG8_LDB(B1, 1, 1); PG8_SCHED; PG8_LDA(At, 1, 0); PG8_STAGE(PG8_SA(0, 1), a2 + hstepA, voffA);
            PG8_WAIT_V(8); PG8_WAIT_L(0); PG8_BAR; PG8_MMA(0, 0, At, B0); PG8_MMA(0, 1, At, B1); PG8_BAR; PG8_SCHED;
            PG8_LDA(At, 1, 1); PG8_STAGE(PG8_SB(1, 0), b3, voffB); PG8_STAGE(PG8_SB(1, 1), b3 + hstepB, voffB); PG8_STAGE(PG8_SA(1, 0), a3, voffA);
            PG8_WAIT_V(8); PG8_WAIT_L(0); PG8_BAR; PG8_MMA(1, 0, At, B0); PG8_MMA(1, 1, At, B1); PG8_BAR; PG8_SCHED;
            } else {
            PG8_LDB(B0, 0, 0); PG8_SCHED; PG8_LDA(At, 0, 0); PG8_STAGE(PG8_SA(1, 1), a1 + hstepA, voffA);
            PG8_WAIT_L(8); PG8_BAR; PG8_WAIT_L(0); PG8_MMA(0, 0, At, B0); PG8_BAR; PG8_SCHED;
            PG8_LDB(B1, 0, 1); PG8_STAGE(PG8_SB(0, 0), b2, voffB);
            PG8_BAR; PG8_WAIT_L(0); PG8_MMA(0, 1, At, B1); PG8_BAR;
            PG8_LDA(At, 0, 1); PG8_STAGE(PG8_SA(0, 0), a2, voffA);
            PG8_BAR; PG8_WAIT_L(0); PG8_MMA(1, 0, At, B0); PG8_BAR; PG8_SCHED;
            PG8_STAGE(PG8_SB(0, 1), b2 + hstepB, voffB);
            PG8_WAIT_V(6); PG8_BAR; PG8_MMA(1, 1, At, B1); PG8_BAR;
            PG8_LDB(B0, 1, 0); PG8_SCHED; PG8_LDA(At, 1, 0); PG8_STAGE(PG8_SA(0, 1), a2 + hstepA, voffA);
            PG8_WAIT_L(8); PG8_BAR; PG8_WAIT_L(0); PG8_MMA(0, 0, At, B0); PG8_BAR; PG8_SCHED;
            PG8_LDB(B1, 1, 1); PG8_STAGE(PG8_SB(1, 0), b3, voffB);
            PG8_BAR; PG8_WAIT_L(0); PG8_MMA(0, 1, At, B1); PG8_BAR;
            PG8_LDA(At, 1, 1); PG8_STAGE(PG8_SA(1, 0), a3, voffA);
            PG8_BAR; PG8_WAIT_L(0); PG8_MMA(1, 0, At, B0); PG8_BAR; PG8_SCHED;
            PG8_STAGE(PG8_SB(1, 1), b3 + hstepB, voffB);
            PG8_WAIT_V(6); PG8_BAR; PG8_MMA(1, 1, At, B1); PG8_BAR;
            }
        }
        if constexpr (ALIGN_EPI) { if (wr == 0) PG8_BAR; }
        E(acc, cur, wr, wc, fr, fq);
        if (!has_next) break;
#pragma unroll
        for (int a = 0; a < 2; ++a)
#pragma unroll
            for (int b = 0; b < 2; ++b)
#pragma unroll
                for (int m = 0; m < 4; ++m)
#pragma unroll
                    for (int n = 0; n < 2; ++n) acc[a][b][m][n] = (f32x4){0.f, 0.f, 0.f, 0.f};
        cur = nxt; cA = nA; cB = nB; ++ui;
        if constexpr (ALIGN_EPI) { if (wr == 1) PG8_BAR; }
    }
    PG8_WAIT_V(0);
    if constexpr (!ALIGN_EPI) { if (wr == 0) PG8_BAR; }
    PG8_BAR;
#undef PG8_SA
#undef PG8_SB
#undef PG8_STAGE
#undef PG8_LDA
#undef PG8_LDB
#undef PG8_MMA
#undef PG8_WAIT_V
#undef PG8_WAIT_L
#undef PG8_BAR
#undef PG8_SCHED
}
}

#define XB_TMO      128
#define XB_XCNT(j)  (256  + 64 * (j))
#define XB_XSUB(j)  (1280 + 64 * (j))
#define XB_XGEN(j)  (2304 + 64 * (j))
#define XB_TOP      3328
#define XB_TOPGEN   3392
#define XCD_BAR_WORDS 3456
#define XB_SPIN_CAP (1u << 18)

__device__ __forceinline__ unsigned xb_ld(unsigned* p)              { return __hip_atomic_load(p, __ATOMIC_RELAXED, __HIP_MEMORY_SCOPE_AGENT); }
__device__ __forceinline__ unsigned xb_add(unsigned* p, unsigned v) { return __hip_atomic_fetch_add(p, v, __ATOMIC_RELAXED, __HIP_MEMORY_SCOPE_AGENT); }
__device__ __forceinline__ unsigned xb_xcc_id() { return (unsigned)__builtin_amdgcn_s_getreg((3 << 11) | 20) & 0xFu; }
#define XB_SPIN(cond, bar) do { unsigned _sp = 0; while (cond) { __builtin_amdgcn_s_sleep(1); \
    if ((++_sp & 255u) == 0u) { if (xb_ld(&(bar)[XB_TMO])) break; if (_sp > XB_SPIN_CAP) { atomicAdd(&(bar)[XB_TMO], 1u); break; } } } } while (0)

struct XcdBarrier {
    unsigned* bar; unsigned x;
    volatile LAS unsigned* st;
};

__device__ __forceinline__ XcdBarrier xcd_barrier_post(unsigned* bar, volatile LAS unsigned* st) {
    XcdBarrier b; b.bar = bar; b.x = xb_xcc_id(); b.st = st;
    if (threadIdx.x == 0) (void)xb_add(&bar[XB_XCNT(b.x)], 1u);
    return b;
}
__device__ __forceinline__ void xcd_barrier_complete(unsigned* bar, unsigned x, unsigned& nloc, unsigned& nx) {
    const unsigned G = gridDim.x * gridDim.y * gridDim.z;
    unsigned sum, cnt, mine, sp = 0u;
    for (;;) {
        sum = 0u; cnt = 0u; mine = 0u;
#pragma unroll
        for (unsigned j = 0; j < 16; ++j) { const unsigned c = xb_ld(&bar[XB_XCNT(j)]); sum += c; cnt += (c > 0u) ? 1u : 0u; mine = (j == x) ? c : mine; }
        if (sum == G) break;
        __builtin_amdgcn_s_sleep(1);
        if ((++sp & 255u) == 0u) { if (xb_ld(&bar[XB_TMO])) break; if (sp > XB_SPIN_CAP) { atomicAdd(&bar[XB_TMO], 1u); break; } }
    }
    nloc = mine > 0u ? mine : 1u; nx = cnt > 0u ? cnt : 1u;
}

__device__ __forceinline__ void xcd_barrier(const XcdBarrier& b) {
    asm volatile("s_waitcnt vmcnt(0)" ::: "memory");
    __syncthreads();
    if (threadIdx.x == 0) {
        unsigned* bar = b.bar;
        __builtin_amdgcn_s_waitcnt(0);
        unsigned nloc = b.st[0], nx = b.st[1];
        if (nloc == 0u) { xcd_barrier_complete(bar, b.x, nloc, nx); b.st[0] = nloc; b.st[1] = nx; }
        const unsigned old = xb_add(&bar[XB_XSUB(b.x)], 1u);
        const unsigned gen = old / nloc;
        if (old + 1u == (gen + 1u) * nloc) {
            __builtin_amdgcn_fence(__ATOMIC_RELEASE, "agent");
            asm volatile("s_waitcnt vmcnt(0)" ::: "memory");
            const unsigned og = xb_add(&bar[XB_TOP], 1u);
            const unsigned tg = og / nx;
            if (og + 1u == (tg + 1u) * nx) xb_add(&bar[XB_TOPGEN], 1u);
            else XB_SPIN(xb_ld(&bar[XB_TOPGEN]) == tg, bar);
            __builtin_amdgcn_fence(__ATOMIC_ACQUIRE, "agent");
            xb_add(&bar[XB_XGEN(b.x)], 1u);
            asm volatile("s_waitcnt vmcnt(0)" ::: "memory");
        } else {
            XB_SPIN(xb_ld(&bar[XB_XGEN(b.x)]) == gen, bar);
            __builtin_amdgcn_fence(__ATOMIC_ACQUIRE, "agent");
            asm volatile("s_waitcnt vmcnt(0)" ::: "memory");
        }
    }
    __syncthreads();
}


struct Args {
    const float* x; const int* pos; const float* g_pre; const float* w_in; const float* g_q_lat; const float* g_kv_lat; const float* w_uq; const float* w_ukv;
    const float* g_qn_a; const float* g_kn_a; const float* g_qn_b; const float* g_kn_b; const float* t5; const float* p_a; const float* p_b; const float* w_o;
    float* out; unsigned char* ws; int ph_lo, ph_hi;
};

DI void p0_transpose_item(const float* W, int N, const float* gk, bf16_t* WT, int ldk, int koff, LAS float* scr, int item, int lane) {
    const int nblk = (N + 63) / 64, kb = item / nblk, nb = item % nblk, k0 = 64 * kb, n0 = 64 * nb;
    const bool nv = (n0 + lane) < N;
    const float* wp = W + (size_t)k0 * N + n0 + (nv ? lane : 0);
    float wv_[64];
#pragma unroll
    for (int i = 0; i < 64; ++i) wv_[i] = wp[(size_t)i * N];
#pragma unroll
    for (int i = 0; i < 64; ++i) { float v = nv ? wv_[i] : 0.f; if (gk) v *= gk[k0 + i]; scr[i * 65 + lane] = v; }
    asm volatile("s_waitcnt lgkmcnt(0)" ::: "memory");
    const int c = lane & 7;
#pragma unroll
    for (int j = 0; j < 8; ++j) { const int n = (lane >> 3) + 8 * j; const LAS float* s = scr + (8 * c) * 65 + n;
        u32x4 o; o.x = pk2(s[0 * 65], s[1 * 65]); o.y = pk2(s[2 * 65], s[3 * 65]); o.z = pk2(s[4 * 65], s[5 * 65]); o.w = pk2(s[6 * 65], s[7 * 65]);
        if (n0 + n < N) *(u32x4*)(WT + (size_t)(n0 + n) * ldk + koff + k0 + 8 * c) = o; }
    asm volatile("s_waitcnt lgkmcnt(0)" ::: "memory");
}
DI void p0_prologue(const Args& a, LAS unsigned char* lds, int G) {
    const int tid = threadIdx.x, lane = tid & 63, wave = tid >> 6;
    LAS float* scr = (LAS float*)(lds + wave * 16640);
    const int gw = blockIdx.x * NWAVES + wave, NGW = G * NWAVES;
    bf16_t* WIN_T = (bf16_t*)(a.ws + WS_WIN_T); bf16_t* WUQ_T = (bf16_t*)(a.ws + WS_WUQ_T); bf16_t* WUKV_T = (bf16_t*)(a.ws + WS_WUKV_T);
    bf16_t* PCAT_T = (bf16_t*)(a.ws + WS_PCAT_T); bf16_t* WO_T = (bf16_t*)(a.ws + WS_WO_T); bf16_t* HN = (bf16_t*)(a.ws + WS_HN);
    constexpr int I_IN = (DM / 64) * ((NCOLS + 63) / 64), I_UQ = (1024 / 64) * (3072 / 64), I_UKV = (512 / 64) * (4096 / 64), I_P = (2048 / 64) * (4096 / 64), I_O = (4096 / 64) * (4096 / 64);
    constexpr int NITEMS = I_IN + I_UQ + I_UKV + 2 * I_P + I_O;
    for (int it = gw; it < NITEMS; it += NGW) {
        int r = it;
        if (r < I_IN) { p0_transpose_item(a.w_in, NCOLS, nullptr, WIN_T, DM, 0, scr, r, lane); continue; } r -= I_IN;
        if (r < I_UQ) { p0_transpose_item(a.w_uq, 3072, a.g_q_lat, WUQ_T, 1024, 0, scr, r, lane); continue; } r -= I_UQ;
        if (r < I_UKV) { p0_transpose_item(a.w_ukv, 4096, a.g_kv_lat, WUKV_T, 512, 0, scr, r, lane); continue; } r -= I_UKV;
        if (r < I_P) { p0_transpose_item(a.p_a, 4096, nullptr, PCAT_T, 4096, 0, scr, r, lane); continue; } r -= I_P;
        if (r < I_P) { p0_transpose_item(a.p_b, 4096, nullptr, PCAT_T, 4096, 2048, scr, r, lane); continue; } r -= I_P;
        p0_transpose_item(a.w_o, 4096, nullptr, WO_T, 4096, 0, scr, r, lane);
    }
    { u32x4* z = (u32x4*)(WIN_T + (size_t)NCOLS * DM); const int n16 = (LDP - NCOLS) * DM * 2 / 16;
      for (int i = blockIdx.x * NTHREADS + tid; i < n16; i += G * NTHREADS) z[i] = (u32x4){0u, 0u, 0u, 0u}; }
    for (int m = gw; m < M; m += NGW) {
        const f32x4* xr = (const f32x4*)(a.x + (size_t)m * DM) + lane; const f32x4* gr = (const f32x4*)a.g_pre + lane;
        f32x4 v[16]; float s = 0.f;
#pragma unroll
        for (int j = 0; j < 16; ++j) { v[j] = xr[64 * j]; s += (v[j].x * v[j].x + v[j].y * v[j].y) + (v[j].z * v[j].z + v[j].w * v[j].w); }
        const float rs = rsqrtf(wave_sum(s) * (1.f / DM) + EPS);
        u32x2* o8 = (u32x2*)(HN + (size_t)m * DM) + lane;
#pragma unroll
        for (int j = 0; j < 16; ++j) { const f32x4 g = gr[64 * j]; u32x2 w; w.x = pk2(v[j].x * rs * g.x, v[j].y * rs * g.y); w.y = pk2(v[j].z * rs * g.z, v[j].w * rs * g.w); o8[64 * j] = w; }
    }
}

DI void p3_prep(const Args& a, LAS unsigned char* lds, int G) {
    const int tid = threadIdx.x, lane = tid & 63, wave = tid >> 6, hl = lane & 31, hh = lane >> 5;
    const bf16_t* PROJ = (const bf16_t*)(a.ws + WS_PROJ); const bf16_t* QRAW = (const bf16_t*)(a.ws + WS_WIN_T); const bf16_t* KVRAW = (const bf16_t*)(a.ws + WS_HN);
    bf16_t* QA = (bf16_t*)((unsigned char*)a.out + DO_QA); bf16_t* KA = (bf16_t*)((unsigned char*)a.out + DO_KA); bf16_t* VAT = (bf16_t*)((unsigned char*)a.out + DO_VAT);
    bf16_t* QB = (bf16_t*)(a.ws + WS_QB); bf16_t* KBn = (bf16_t*)(a.ws + WS_KB); bf16_t* VBT = (bf16_t*)(a.ws + WS_VBT); bf16_t* KIDX = (bf16_t*)(a.ws + WS_KIDX);
    LAS unsigned short* tile0 = (LAS unsigned short*)lds;
    LAS float* rskv = (LAS float*)(lds + 81920);
    const f32x4 gqa = *(const f32x4*)(a.g_qn_a + 4 * hl); const float gqa1 = a.g_qn_a[128 + hl], gqa2 = a.g_qn_a[160 + hl];
    const f32x4 gka = *(const f32x4*)(a.g_kn_a + 4 * hl); const float gka1 = a.g_kn_a[128 + hl], gka2 = a.g_kn_a[160 + hl];
    const f32x4 gqb = *(const f32x4*)(a.g_qn_b + 4 * hl); const f32x4 gkb = *(const f32x4*)(a.g_kn_b + 4 * hl);
    const float inv_freq = exp2f(-(float)hl * 0.41524101186092029f);
    for (int tl0 = blockIdx.x; tl0 < M / 64; tl0 += G) {
        const int m0 = tl0 * 64;
#pragma unroll 1
        for (int i = 0; i < 8; ++i) {
            const int tl = wave * 8 + i, m = m0 + tl, b = m / L, l = m % L;
            const bf16_t* pr = PROJ + (size_t)m * LDP;
            const u32x4 c0 = *(const u32x4*)(pr + C_CQ + lane * 16), c1 = *(const u32x4*)(pr + C_CQ + lane * 16 + 8), c2 = *(const u32x4*)(pr + C_CKV + lane * 8);
            const int posm = a.pos[m];
            const unsigned short kr1u = pr[C_KROPE + hl], kr2u = pr[C_KROPE + 32 + hl];
            const u32x2 wkb = *(const u32x2*)(pr + C_KB + 4 * hl);
            u32x2 wki = (u32x2){0u, 0u}; if (lane < 16) wki = *(const u32x2*)(pr + C_KIDX + 4 * lane);
            u32x2 wqa[8], wka[8], wqb[8]; unsigned short q1u[8], q2u[8];
#pragma unroll
            for (int hp = 0; hp < 8; ++hp) { const int head = 2 * hp + hh;
                const bf16_t* sq = QRAW + (size_t)m * 3072 + head * 192; const bf16_t* sk = KVRAW + (size_t)m * 4096 + head * 256;
                wqa[hp] = *(const u32x2*)(sq + 4 * hl); q1u[hp] = sq[128 + hl]; q2u[hp] = sq[160 + hl];
                wka[hp] = *(const u32x2*)(sk + 4 * hl); wqb[hp] = *(const u32x2*)(pr + C_QB + head * 128 + 4 * hl); }
            __builtin_amdgcn_sched_barrier(0);
            const float rs_q = rsqrtf(wave_sum(sumsq8(c0) + sumsq8(c1)) * (1.f / 1024.f) + EPS);
            const float rs_kv = rsqrtf(wave_sum(sumsq8(c2)) * (1.f / 512.f) + EPS);
            if (lane == 0) rskv[tl] = rs_kv;
            const float ang = (float)posm * inv_freq;
            double tt = (double)ang * 0.15915494309189535; tt -= floor(tt); const float frac = (float)tt;
            const float cs = __builtin_amdgcn_cosf(frac), sn = __builtin_amdgcn_sinf(frac);
            const float kr1 = bf2f(kr1u), kr2 = bf2f(kr2u);
#pragma unroll
            for (int hp = 0; hp < 8; ++hp) {
                const int head = 2 * hp + hh;
                {
                    const u32x2 w = wqa[hp];
                    const float x0 = lo16(w.x) * rs_q, x1 = hi16(w.x) * rs_q, x2 = lo16(w.y) * rs_q, x3 = hi16(w.y) * rs_q;
                    const float r1 = bf2f(q1u[hp]) * rs_q, r2 = bf2f(q2u[hp]) * rs_q;
                    const float ss = half_sum((x0 * x0 + x1 * x1) + (x2 * x2 + x3 * x3) + (r1 * r1 + r2 * r2));
                    const float ri = rsqrtf(ss * (1.f / 192.f) + EPS);
                    const float y1 = r1 * ri * gqa1, y2 = r2 * ri * gqa2;
                    const float o1 = (y1 * cs - y2 * sn) * QSA, o2 = (y1 * sn + y2 * cs) * QSA;
                    bf16_t* dst = QA + ((size_t)(b * 16 + head) * L + l) * 192;
                    u32x2 o; o.x = pk2(x0 * ri * gqa.x * QSA, x1 * ri * gqa.y * QSA); o.y = pk2(x2 * ri * gqa.z * QSA, x3 * ri * gqa.w * QSA);
                    *(u32x2*)(dst + 4 * hl) = o; dst[128 + hl] = (bf16_t)(pk2(o1, 0.f) & 0xffffu); dst[160 + hl] = (bf16_t)(pk2(o2, 0.f) & 0xffffu);
                }
                {
                    const u32x2 w = wka[hp];
                    const float x0 = lo16(w.x) * rs_kv, x1 = hi16(w.x) * rs_kv, x2 = lo16(w.y) * rs_kv, x3 = hi16(w.y) * rs_kv;
                    const float ss = half_sum((x0 * x0 + x1 * x1) + (x2 * x2 + x3 * x3) + (kr1 * kr1 + kr2 * kr2));
                    const float ri = rsqrtf(ss * (1.f / 192.f) + EPS);
                    const float y1 = kr1 * ri * gka1, y2 = kr2 * ri * gka2;
                    const float o1 = y1 * cs - y2 * sn, o2 = y1 * sn + y2 * cs;
                    bf16_t* dst = KA + ((size_t)(b * 16 + head) * L + l) * 192;
                    u32x2 o; o.x = pk2(x0 * ri * gka.x, x1 * ri * gka.y); o.y = pk2(x2 * ri * gka.z, x3 * ri * gka.w);
                    *(u32x2*)(dst + 4 * hl) = o; dst[128 + hl] = (bf16_t)(pk2(o1, 0.f) & 0xffffu); dst[160 + hl] = (bf16_t)(pk2(o2, 0.f) & 0xffffu);
                }
                {
                    const u32x2 w = wqb[hp];
                    const float x0 = lo16(w.x), x1 = hi16(w.x), x2 = lo16(w.y), x3 = hi16(w.y);
                    const float ss = half_sum((x0 * x0 + x1 * x1) + (x2 * x2 + x3 * x3));
                    const float ri = rsqrtf(ss * (1.f / 128.f) + EPS) * QSB;
                    u32x2 o; o.x = pk2(x0 * ri * gqb.x, x1 * ri * gqb.y); o.y = pk2(x2 * ri * gqb.z, x3 * ri * gqb.w);
                    *(u32x2*)(QB + ((size_t)m * 16 + head) * 128 + 4 * hl) = o;
                }
            }
            {
                const u32x2 w = wkb;
                const float x0 = lo16(w.x), x1 = hi16(w.x), x2 = lo16(w.y), x3 = hi16(w.y);
                const float ss = half_sum((x0 * x0 + x1 * x1) + (x2 * x2 + x3 * x3));
                const float ri = rsqrtf(ss * (1.f / 128.f) + EPS);
                u32x2 o; o.x = pk2(x0 * ri * gkb.x, x1 * ri * gkb.y); o.y = pk2(x2 * ri * gkb.z, x3 * ri * gkb.w);
                if (hh == 0) *(u32x2*)(KBn + (size_t)m * 128 + 4 * hl) = o;
            }
            if (lane < 16) *(u32x2*)(KIDX + (size_t)m * 64 + 4 * lane) = wki;
        }
        __syncthreads();
        const int b = m0 / L, l0 = m0 % L;
        u32x4 pv[4][2];
#pragma unroll
        for (int mm = 0; mm < 4; ++mm) { const int tl = tid >> 3, ch = tid & 7;
            const bf16_t* src = KVRAW + (size_t)(m0 + tl) * 4096 + mm * 256 + 128 + 16 * ch;
            pv[mm][0] = *(const u32x4*)src; pv[mm][1] = *(const u32x4*)(src + 8); }
        for (int mat0 = 0; mat0 < 17; mat0 += 4) {
#pragma unroll
            for (int mm = 0; mm < 4; ++mm) { const int mat = mat0 + mm; if (mat < 17) {
                const int tl = tid >> 3, ch = tid & 7; LAS unsigned short* tile = tile0 + mm * (64 * 136);
                *(LAS u32x4*)(tile + tl * 136 + 16 * ch) = pv[mm][0]; *(LAS u32x4*)(tile + tl * 136 + 16 * ch + 8) = pv[mm][1]; } }
            __syncthreads();
#pragma unroll
            for (int mm = 0; mm < 4; ++mm) { const int mat = mat0 + 4 + mm; if (mat < 17) {
                const int tl = tid >> 3, ch = tid & 7;
                const bf16_t* src = (mat < 16) ? (KVRAW + (size_t)(m0 + tl) * 4096 + mat * 256 + 128 + 16 * ch) : (PROJ + (size_t)(m0 + tl) * LDP + C_VB + 16 * ch);
                pv[mm][0] = *(const u32x4*)src; pv[mm][1] = *(const u32x4*)(src + 8); } }
#pragma unroll
            for (int mm = 0; mm < 4; ++mm) { const int mat = mat0 + mm; if (mat < 17) {
                const int d = tid >> 2, tg = tid & 3; float f[16]; const LAS unsigned short* tile = tile0 + mm * (64 * 136);
#pragma unroll
                for (int i = 0; i < 16; ++i) { const float sc = (mat < 16) ? rskv[16 * tg + i] : 1.f; f[i] = bf2f(tile[(16 * tg + i) * 136 + d]) * sc; }
                bf16_t* dst = ((mat < 16) ? (VAT + ((size_t)(b * 16 + mat) * 128 + d) * L) : (VBT + ((size_t)b * 128 + d) * L)) + l0 + 16 * tg;
                u32x4 w0, w1; w0.x = pk2(f[0], f[1]); w0.y = pk2(f[2], f[3]); w0.z = pk2(f[4], f[5]); w0.w = pk2(f[6], f[7]);
                w1.x = pk2(f[8], f[9]); w1.y = pk2(f[10], f[11]); w1.z = pk2(f[12], f[13]); w1.w = pk2(f[14], f[15]);
                *(u32x4*)dst = w0; *(u32x4*)(dst + 8) = w1; } }
            __syncthreads();
        }
    }
}

constexpr int VT_PITCH = 136, VT_BYTES = 128 * VT_PITCH;
constexpr int ATT_TB_OFF = 131072, ATT_MASK_OFF = ATT_TB_OFF + 129 * 16 * 4, ATT_KST_OFF = ATT_MASK_OFF + 4096;
static_assert(ATT_KST_OFF + 16384 <= LDS_BYTES, "LDS map");
DI float silu(float g) { return g * __builtin_amdgcn_rcpf(1.f + __expf(-g)); }

#define ATT_WRITE_NEXT() do { if (pre) { LAS unsigned char* kbn = kbase + (buf ^ 1) * KT_BYTES; LAS unsigned char* vbn = vbase + (buf ^ 1) * VT_BYTES; \
            _Pragma("unroll") for (int i = 0; i < KCH; ++i) *(LAS u32x4*)(kbn + klo0 + 2048 * i) = kreg[i]; \
            _Pragma("unroll") for (int i = 0; i < 2; ++i) { *(LAS u32x2*)(vbn + vlo0 + 64 * VT_PITCH * i) = (u32x2){vreg[i].x, vreg[i].y}; *(LAS u32x2*)(vbn + vlo0 + 64 * VT_PITCH * i + 8) = (u32x2){vreg[i].z, vreg[i].w}; } } } while (0)
template <int DQK, bool MB>
DI void attn_core(LAS unsigned char* lds, const bf16_t* Kg, const bf16_t* Vtg, const bf16_t* q0p, const bf16_t* q1p, int nt, int qi0, int qi1, int wave_qmax,
                  const LAS unsigned long long* sm0, const LAS unsigned long long* sm1, const LAS float* tb, const int* posb, int pt0, int pt1,
                  f32x4 (&o)[2][8], float (&lsum)[2]) {
    constexpr int KK = DQK / 32, KT_BYTES = 64 * DQK * 2, KCH = (64 * DQK / 8) / NTHREADS, DCH = DQK / 8;
    int tid_o = threadIdx.x; asm volatile("" : "+v"(tid_o));
    const int tid = tid_o, lane = tid & 63, r = lane & 15, q = lane >> 4;
    constexpr bool ST = false;
    constexpr int NBUF = ST ? 3 : 2, AHEAD = ST ? 2 : 1;
    LAS unsigned char* kbase = lds; LAS unsigned char* vbase = lds + NBUF * KT_BYTES;
    constexpr int KR = 0, KH = KK - KR;
    bf16x8 qf[2][KH];
#pragma unroll
    for (int kk = 0; kk < KH; ++kk) { qf[0][kk] = *(const bf16x8*)(q0p + 32 * kk + 8 * q); qf[1][kk] = *(const bf16x8*)(q1p + 32 * kk + 8 * q); }
#pragma unroll
    for (int ct = 0; ct < 2; ++ct) { lsum[ct] = 0.f;
#pragma unroll
        for (int dt = 0; dt < 8; ++dt) o[ct][dt] = (f32x4){0.f, 0.f, 0.f, 0.f}; }
    float mrow[2] = {-1e30f, -1e30f};
    float tbfar = 0.f; if (MB) tbfar = tb[128 * 16 + r];
    const int skey = tid >> 3, sch = tid & 7;
    const int kgo0 = skey * DQK + sch * 8;
    int klo0; { const int st = (skey >> 4) * KK + (sch >> 2), ob = (skey & 15) * 64 + (sch & 3) * 16; klo0 = st * 1024 + (ob ^ (((ob >> 9) & 1) << 5)); }
    const int vgo0 = skey * L + sch * 8, vlo0 = skey * VT_PITCH + sch * 16;
    u32x4 kreg[KCH], vreg[2];
#pragma unroll
    for (int i = 0; i < KCH; ++i) kreg[i] = *(const u32x4*)(Kg + kgo0 + 64 * i);
#pragma unroll
    for (int i = 0; i < 2; ++i) vreg[i] = *(const u32x4*)(Vtg + vgo0 + 64 * i * L);
#pragma unroll
    for (int i = 0; i < KCH; ++i) *(LAS u32x4*)(kbase + klo0 + 2048 * i) = kreg[i];
#pragma unroll
    for (int i = 0; i < 2; ++i) { *(LAS u32x2*)(vbase + vlo0 + 64 * VT_PITCH * i) = (u32x2){vreg[i].x, vreg[i].y}; *(LAS u32x2*)(vbase + vlo0 + 64 * VT_PITCH * i + 8) = (u32x2){vreg[i].z, vreg[i].w}; }
    if (ST && nt > 1) {
#pragma unroll
        for (int i = 0; i < KCH; ++i) kreg[i] = *(const u32x4*)(Kg + (size_t)64 * DQK + kgo0 + 64 * i);
#pragma unroll
        for (int i = 0; i < 2; ++i) vreg[i] = *(const u32x4*)(Vtg + 64 + vgo0 + 64 * i * L);
#pragma unroll
        for (int i = 0; i < KCH; ++i) *(LAS u32x4*)(kbase + KT_BYTES + klo0 + 2048 * i) = kreg[i];
#pragma unroll
        for (int i = 0; i < 2; ++i) { *(LAS u32x2*)(vbase + VT_BYTES + vlo0 + 64 * VT_PITCH * i) = (u32x2){vreg[i].x, vreg[i].y}; *(LAS u32x2*)(vbase + VT_BYTES + vlo0 + 64 * VT_PITCH * i + 8) = (u32x2){vreg[i].z, vreg[i].w}; }
    }
    __syncthreads();
    const int grp = __builtin_amdgcn_readfirstlane(tid >> 8);
#pragma unroll
    for (int kk = 0; kk < KH; ++kk) asm volatile("" :: "v"(qf[0][kk]), "v"(qf[1][kk]));
    if (ST && grp == 1) { asm volatile("" ::: "memory"); __builtin_amdgcn_s_barrier(); asm volatile("" ::: "memory"); }
    const int ob0 = r * 64 + q * 16, koff = ob0 ^ (((ob0 >> 9) & 1) << 5);
    int m0lo = 0, m0hi = 0, m1lo = 0, m1hi = 0;
    if (MB) { const unsigned long long wa = sm0[lane & 31], wb = sm1[lane & 31];
        m0lo = (int)(unsigned)wa; m0hi = (int)(unsigned)(wa >> 32); m1lo = (int)(unsigned)wb; m1hi = (int)(unsigned)(wb >> 32); }
    int kt_far = nt;
    if (MB) { const int tl = (lane < nt) ? lane : (nt - 1); const int pl = posb[64 * tl + 63];
        kt_far = __popcll(__ballot(lane < nt && (pt0 - pl) >= 128)); }
    int buf = 0;
#pragma unroll
    for (int pass = 0; pass < (MB ? 2 : 1); ++pass)
    for (int kt = (pass == 0 ? 0 : kt_far); kt < ((MB && pass == 0) ? kt_far : nt); ++kt) {
        const bool pre = (kt + AHEAD < nt);
        if (pre) {
#pragma unroll
            for (int i = 0; i < KCH; ++i) kreg[i] = *(const u32x4*)(Kg + (size_t)(kt + AHEAD) * 64 * DQK + kgo0 + 64 * i);
#pragma unroll
            for (int i = 0; i < 2; ++i) vreg[i] = *(const u32x4*)(Vtg + (kt + AHEAD) * 64 + vgo0 + 64 * i * L);
        }
        const bool act = MB || 64 * kt <= wave_qmax;
        const LAS unsigned char* kb = kbase + buf * KT_BYTES; const LAS unsigned char* vb = vbase + buf * VT_BYTES;
        f32x4 s[4][2];
        if (act) {
            bf16x8 kfa[KK], kfb[KK];
#pragma unroll
            for (int kk = 0; kk < KK; ++kk) kfa[kk] = *(const LAS bf16x8*)(kb + kk * 1024 + koff);
#pragma unroll
            for (int ks = 0; ks < 4; ++ks) {
                if (ks < 3) {
#pragma unroll
                    for (int kk = 0; kk < KK; ++kk) { const bf16x8 t = *(const LAS bf16x8*)(kb + ((ks + 1) * KK + kk) * 1024 + koff); if (ks & 1) kfa[kk] = t; else kfb[kk] = t; }
                }
                __builtin_amdgcn_sched_barrier(0);
                s[ks][0] = (f32x4){0.f, 0.f, 0.f, 0.f}; s[ks][1] = (f32x4){0.f, 0.f, 0.f, 0.f};
#pragma unroll
                for (int kk = 0; kk < KK; ++kk) { const bf16x8 kf = (ks & 1) ? kfb[kk] : kfa[kk];
                    const bf16x8 qa0 = qf[0][kk], qa1 = qf[1][kk];
                    s[ks][0] = __builtin_amdgcn_mfma_f32_16x16x32_bf16(kf, qa0, s[ks][0], 0, 0, 0);
                    s[ks][1] = __builtin_amdgcn_mfma_f32_16x16x32_bf16(kf, qa1, s[ks][1], 0, 0, 0); }
                __builtin_amdgcn_sched_barrier(0);
            }
        }
        if (ST) { asm volatile("" ::: "memory"); __builtin_amdgcn_s_barrier(); asm volatile("" ::: "memory"); }
        if (act) {
            if (MB) {
                const unsigned long long mw0 = (unsigned long long)(unsigned)__builtin_amdgcn_readlane(m0lo, kt) | ((unsigned long long)(unsigned)__builtin_amdgcn_readlane(m0hi, kt) << 32);
                const unsigned long long mw1 = (unsigned long long)(unsigned)__builtin_amdgcn_readlane(m1lo, kt) | ((unsigned long long)(unsigned)__builtin_amdgcn_readlane(m1hi, kt) << 32);
                if (pass == 0) {
#pragma unroll
                    for (int ks = 0; ks < 4; ++ks) { const unsigned b0 = (unsigned)(mw0 >> (16 * ks + 4 * q)) & 0xFu, b1 = (unsigned)(mw1 >> (16 * ks + 4 * q)) & 0xFu;
#pragma unroll
                        for (int j = 0; j < 4; ++j) { s[ks][0][j] = ((b0 >> j) & 1u) ? s[ks][0][j] + tbfar : -INFINITY; s[ks][1][j] = ((b1 >> j) & 1u) ? s[ks][1][j] + tbfar : -INFINITY; } }
                } else
                {
                float bv[4][2][4];
#pragma unroll
                for (int ks = 0; ks < 4; ++ks) { const i32x4 pk = *(const i32x4*)(posb + 64 * kt + 16 * ks + 4 * q);
#pragma unroll
                    for (int j = 0; j < 4; ++j) { const int d0 = min(max(pt0 - pk[j], 0), 128), d1 = min(max(pt1 - pk[j], 0), 128);
                        bv[ks][0][j] = tb[d0 * 16 + r]; bv[ks][1][j] = tb[d1 * 16 + r]; } }
                __builtin_amdgcn_sched_barrier(0);
#pragma unroll
                for (int ks = 0; ks < 4; ++ks) { const unsigned b0 = (unsigned)(mw0 >> (16 * ks + 4 * q)) & 0xFu, b1 = (unsigned)(mw1 >> (16 * ks + 4 * q)) & 0xFu;
#pragma unroll
                    for (int j = 0; j < 4; ++j) { s[ks][0][j] = ((b0 >> j) & 1u) ? s[ks][0][j] + bv[ks][0][j] : -INFINITY; s[ks][1][j] = ((b1 >> j) & 1u) ? s[ks][1][j] + bv[ks][1][j] : -INFINITY; } }
                }
            } else if (64 * kt + 63 > wave_qmax - 31) {
#pragma unroll
                for (int ks = 0; ks < 4; ++ks)
#pragma unroll
                    for (int j = 0; j < 4; ++j) { const int key = 64 * kt + 16 * ks + 4 * q + j;
                        s[ks][0][j] = (key <= qi0) ? s[ks][0][j] : -INFINITY; s[ks][1][j] = (key <= qi1) ? s[ks][1][j] : -INFINITY; }
            }
            float alpha2[2];
#pragma unroll
            for (int ct = 0; ct < 2; ++ct) {
                float mx = -INFINITY;
#pragma unroll
                for (int ks = 0; ks < 4; ++ks)
#pragma unroll
                    for (int j = 0; j < 4; ++j) mx = fmaxf(mx, s[ks][ct][j]);
                mx = fmaxf(mx, __shfl_xor(mx, 16)); mx = fmaxf(mx, __shfl_xor(mx, 32));
                const float mnew = fmaxf(mrow[ct], mx), alpha = __builtin_amdgcn_exp2f(mrow[ct] - mnew);
                mrow[ct] = mnew;
                float ps = 0.f;
#pragma unroll
                for (int ks = 0; ks < 4; ++ks)
#pragma unroll
                    for (int j = 0; j < 4; ++j) { const float p = __builtin_amdgcn_exp2f(s[ks][ct][j] - mnew); s[ks][ct][j] = p; ps += p; }
                lsum[ct] = lsum[ct] * alpha + ps; alpha2[ct] = alpha;
            }
            {
#pragma unroll
                for (int ct = 0; ct < 2; ++ct)
#pragma unroll
                    for (int dt = 0; dt < 8; ++dt) o[ct][dt] *= alpha2[ct];
            }
#pragma unroll
            for (int kb2 = 0; kb2 < 2; ++kb2) {
                bf16x8 pb[2];
#pragma unroll
                for (int ct = 0; ct < 2; ++ct) { u32x4 w; w.x = pk2(s[2 * kb2][ct][0], s[2 * kb2][ct][1]); w.y = pk2(s[2 * kb2][ct][2], s[2 * kb2][ct][3]);
                    w.z = pk2(s[2 * kb2 + 1][ct][0], s[2 * kb2 + 1][ct][1]); w.w = pk2(s[2 * kb2 + 1][ct][2], s[2 * kb2 + 1][ct][3]); pb[ct] = __builtin_bit_cast(bf16x8, w); }
                bf16x8 vf[8];
#pragma unroll
                for (int dt = 0; dt < 8; ++dt) { const LAS unsigned char* vp = vb + (16 * dt + r) * VT_PITCH + (32 * kb2 + 4 * q) * 2;
                    const s16x4 lo = *(const LAS s16x4*)vp, hi = *(const LAS s16x4*)(vp + 32);
                    vf[dt] = __builtin_shufflevector(lo, hi, 0, 1, 2, 3, 4, 5, 6, 7); }
                __builtin_amdgcn_sched_barrier(0);
#pragma unroll
                for (int dt = 0; dt < 8; ++dt) {
                    o[0][dt] = __builtin_amdgcn_mfma_f32_16x16x32_bf16(vf[dt], pb[0], o[0][dt], 0, 0, 0);
                    o[1][dt] = __builtin_amdgcn_mfma_f32_16x16x32_bf16(vf[dt], pb[1], o[1][dt], 0, 0, 0); }
                __builtin_amdgcn_sched_barrier(0);
            }
        }
        if (pre) { const int nb = ST ? ((buf == 0) ? 2 : buf - 1) : (buf ^ 1); LAS unsigned char* kbn = kbase + nb * KT_BYTES; LAS unsigned char* vbn = vbase + nb * VT_BYTES;
#pragma unroll
            for (int i = 0; i < KCH; ++i) *(LAS u32x4*)(kbn + klo0 + 2048 * i) = kreg[i];
#pragma unroll
            for (int i = 0; i < 2; ++i) { *(LAS u32x2*)(vbn + vlo0 + 64 * VT_PITCH * i) = (u32x2){vreg[i].x, vreg[i].y}; *(LAS u32x2*)(vbn + vlo0 + 64 * VT_PITCH * i + 8) = (u32x2){vreg[i].z, vreg[i].w}; } }
        __syncthreads();
        buf = ST ? ((buf == 2) ? 0 : buf + 1) : (buf ^ 1);
    }
    if (ST && grp == 0) { asm volatile("" ::: "memory"); __builtin_amdgcn_s_barrier(); asm volatile("" ::: "memory"); }
#pragma unroll
    for (int ct = 0; ct < 2; ++ct) { float l = lsum[ct]; l += __shfl_xor(l, 16); l += __shfl_xor(l, 32); lsum[ct] = l; }
}

DI int crow(int i, int h) { return (i & 3) + 8 * (i >> 2) + 4 * h; }

DI void indexer_unit(LAS unsigned char* lds, LAS unsigned long long* smask_w, const bf16_t* PROJ, const bf16_t* KIDXb, const int* posb, int mb0  , int t_0, int njp, int wave, int lane_in) {
    int lane = lane_in; asm volatile("" : "+v"(lane));
    const int tid = wave * 64 + lane, r = lane & 31, h = lane >> 5;
    LAS unsigned char* kst = lds + ATT_KST_OFF;
    LAS float* sc0 = (LAS float*)(lds + wave * 16384); LAS float* sc1 = sc0 + 2048;
    const int srow = tid >> 3, sch = tid & 7, slo = srow * 128 + ((sch ^ ((srow >> 1) & 7)) * 16);
    { const u32x4 v = *(const u32x4*)(KIDXb + (size_t)srow * 64 + sch * 8); *(LAS u32x4*)(kst + slo) = v; }
    bf16x8 aq[2][4]; float wv[2][16];
#pragma unroll
    for (int ct = 0; ct < 2; ++ct) { const bf16_t* pr = PROJ + (size_t)(mb0 + ct) * LDP;
#pragma unroll
        for (int s2 = 0; s2 < 4; ++s2) aq[ct][s2] = *(const bf16x8*)(pr + C_QIDX + r * 64 + 16 * s2 + 8 * h);
#pragma unroll
        for (int i = 0; i < 16; ++i) wv[ct][i] = bf2f(pr[C_WIDX + crow(i, h)]) * 0.17677669529663687f; }
    const int pos_t0 = posb[t_0], pos_t1 = posb[t_0 + 1];
    __syncthreads();
    for (int jp = 0; jp < njp; ++jp) {
        const bool pre = (jp + 1 < njp);
        u32x4 preg = (u32x4){0u, 0u, 0u, 0u};
        if (pre) preg = *(const u32x4*)(KIDXb + (size_t)(64 * (jp + 1) + srow) * 64 + sch * 8);
        const LAS unsigned char* kb = kst + (jp & 1) * 8192;
        float tot[2][2];
#pragma unroll
        for (int hh = 0; hh < 2; ++hh) {
            const int rowl = 32 * hh + r; const LAS unsigned char* rb = kb + rowl * 128; const int sw = (rowl >> 1) & 7;
            bf16x8 bk[4];
#pragma unroll
            for (int s2 = 0; s2 < 4; ++s2) bk[s2] = *(const LAS bf16x8*)(rb + (((2 * s2 + h) ^ sw) * 16));
#pragma unroll
            for (int ct = 0; ct < 2; ++ct) {
                f32x16 acc;
#pragma unroll
                for (int i = 0; i < 16; ++i) acc[i] = 0.f;
#pragma unroll
                for (int s2 = 0; s2 < 4; ++s2) acc = __builtin_amdgcn_mfma_f32_32x32x16_bf16(aq[ct][s2], bk[s2], acc, 0, 0, 0);
                float p = 0.f;
#pragma unroll
                for (int i = 0; i < 16; ++i) p += wv[ct][i] * __builtin_amdgcn_fmed3f(acc[i], 0.f, __builtin_inff());
                p += __shfl_xor(p, 32);
                tot[ct][hh] = p;
            }
        }
        const int key = 64 * jp + lane; const int pk = posb[key];
        sc0[key] = (pk <= pos_t0) ? (h ? tot[0][1] : tot[0][0]) : -INFINITY;
        sc1[key] = (pk <= pos_t1) ? (h ? tot[1][1] : tot[1][0]) : -INFINITY;
        if (pre) *(LAS u32x4*)(kst + ((jp + 1) & 1) * 8192 + slo) = preg;
        __syncthreads();
    }
    {
        unsigned ua[32], ub[32]; int na = 0, nb2 = 0;
#pragma unroll
        for (int i = 0; i < 32; ++i) { float fa = -INFINITY, fb = -INFINITY; if (i < njp) { fa = sc0[64 * i + lane]; fb = sc1[64 * i + lane]; }
            const unsigned ba = __float_as_uint(fa), bb = __float_as_uint(fb);
            ua[i] = ba ^ ((ba >> 31) ? 0xFFFFFFFFu : 0x80000000u); ub[i] = bb ^ ((bb >> 31) ? 0xFFFFFFFFu : 0x80000000u);
            na += (ua[i] != 0x007FFFFFu) ? 1 : 0; nb2 += (ub[i] != 0x007FFFFFu) ? 1 : 0; }
        auto wave_total2 = [&](int ca, int cb, int& ta, int& tb) __attribute__((always_inline)) {
            int x = ca | (cb << 16);
            x += __builtin_amdgcn_update_dpp(0, x, 0xB1, 0xF, 0xF, true); x += __builtin_amdgcn_update_dpp(0, x, 0x4E, 0xF, 0xF, true);
            x += __builtin_amdgcn_update_dpp(0, x, 0x141, 0xF, 0xF, true); x += __builtin_amdgcn_update_dpp(0, x, 0x140, 0xF, 0xF, true);
            const int t = __builtin_amdgcn_readlane(x, 0) + __builtin_amdgcn_readlane(x, 16) + __builtin_amdgcn_readlane(x, 32) + __builtin_amdgcn_readlane(x, 48);
            ta = t & 0xFFFF; tb = (t >> 16) & 0xFFFF; };
        int ta, tb; wave_total2(na, nb2, ta, tb);
        unsigned Ta = 0x00800000u, Tb = 0x00800000u;
        bool ra = ta > 256, rb = tb > 256;
        if (ra) Ta = 0u; if (rb) Tb = 0u;
#pragma unroll 1
        for (int bit = 31; bit >= 0 && (ra || rb); --bit) {
            const unsigned ca = Ta | (1u << bit), cb = Tb | (1u << bit); int cnta = 0, cntb = 0;
#pragma unroll
            for (int i = 0; i < 32; ++i) { cnta += (ua[i] >= ca) ? 1 : 0; cntb += (ub[i] >= cb) ? 1 : 0; }
            int wa_, wb_; wave_total2(cnta, cntb, wa_, wb_);
            if (ra) { if (wa_ >= 256) Ta = ca; if (wa_ == 256) ra = false; }
            if (rb) { if (wb_ >= 256) Tb = cb; if (wb_ == 256) rb = false; }
        }
#pragma unroll
        for (int i = 0; i < 32; ++i) { const unsigned long long wa = __ballot(ua[i] >= Ta), wb = __ballot(ub[i] >= Tb); if (lane == 0) { smask_w[i] = wa; smask_w[32 + i] = wb; } }
    }
}

template <bool DOA, bool DOB>
DI void p4_attention(const Args& a, LAS unsigned char* lds, int G) {
    const int tid = threadIdx.x, lane = tid & 63, wave = __builtin_amdgcn_readfirstlane(tid >> 6);
    const bf16_t* PROJ = (const bf16_t*)(a.ws + WS_PROJ);
    const bf16_t* QA = (const bf16_t*)((const unsigned char*)a.out + DO_QA); const bf16_t* KA = (const bf16_t*)((const unsigned char*)a.out + DO_KA); const bf16_t* VAT = (const bf16_t*)((const unsigned char*)a.out + DO_VAT);
    const bf16_t* QB = (const bf16_t*)(a.ws + WS_QB); const bf16_t* KBn = (const bf16_t*)(a.ws + WS_KB); const bf16_t* VBT = (const bf16_t*)(a.ws + WS_VBT); const bf16_t* KIDX = (const bf16_t*)(a.ws + WS_KIDX);
    bf16_t* OCAT = (bf16_t*)(a.ws + WS_HN);
    LAS float* tb = (LAS float*)(lds + ATT_TB_OFF);
    LAS unsigned long long* smask = (LAS unsigned long long*)(lds + ATT_MASK_OFF);
    if (DOB) for (int e = tid; e < 129 * 16; e += NTHREADS) { const int d = e >> 4, hd = e & 15; int bk;
        if (d < 16) bk = d; else { bk = 16 + (int)(logf((float)d / 16.f) / 2.0794415416798357f * 16.f); bk = bk < 31 ? bk : 31; }
        tb[e] = a.t5[bk * 16 + hd] * LOG2E; }
    __syncthreads();
    f32x4 o[2][8]; float lsum[2];
    if (DOA) for (int it = blockIdx.x; it < 256; it += G) {
        const int xq = it & 7, yq = it >> 3, gq = yq >> 2, pq = yq & 3;
        for (int j = 0; j < 4; ++j) {
            const int combo = xq * 16 + 2 * gq + (j >> 1), b = combo >> 4, hd = combo & 15;
            const bf16_t* Kg = KA + (size_t)(b * 16 + hd) * L * 192; const bf16_t* Vtg = VAT + (size_t)(b * 16 + hd) * 128 * L; const bf16_t* Qg = QA + (size_t)(b * 16 + hd) * L * 192;
            const int qb = (j & 1) ? pq : 7 - pq;
            int lo_ = lane; asm volatile("" : "+v"(lo_)); const int r = lo_ & 15, q = lo_ >> 4;
            const int q0 = qb * 256, qi0 = q0 + 32 * wave + r, qi1 = qi0 + 16;
            attn_core<192, false>(lds, Kg, Vtg, Qg + (size_t)qi0 * 192, Qg + (size_t)qi1 * 192, 4 * (qb + 1), qi0, qi1, q0 + 32 * wave + 31, nullptr, nullptr, nullptr, nullptr, 0, 0, o, lsum);
#pragma unroll
            for (int ct = 0; ct < 2; ++ct) { const float inv = __builtin_amdgcn_rcpf(lsum[ct]); const size_t m = (size_t)b * L + (ct ? qi1 : qi0);
                const bf16_t* gp = PROJ + m * LDP + C_GA + hd * 128 + 4 * q; bf16_t* op = OCAT + m * 4096 + hd * 128 + 4 * q;
#pragma unroll
                for (int dt = 0; dt < 8; ++dt) { const u32x2 g = *(const u32x2*)(gp + 16 * dt); const f32x4 v = o[ct][dt] * inv;
                    u32x2 w; w.x = pk2(v[0] * silu(lo16(g.x)), v[1] * silu(hi16(g.x))); w.y = pk2(v[2] * silu(lo16(g.y)), v[3] * silu(hi16(g.y)));
                    *(u32x2*)(op + 16 * dt) = w; } }
        }
    }
    if (DOB) for (int it = blockIdx.x; it < 256; it += G) {
        const int b = it & 7, jx = it >> 3;
        const int* posb = a.pos + (size_t)b * L; const bf16_t* KIDXb = KIDX + (size_t)b * L * 64;
        const bf16_t* Kg = KBn + (size_t)b * L * 128; const bf16_t* Vtg = VBT + (size_t)b * 128 * L;
        for (int j = 0; j < 4; ++j) {
            const int un = (j == 0) ? jx : (j == 1) ? 63 - jx : (j == 2) ? 64 + jx : 127 - jx;
            int lo_ = lane; asm volatile("" : "+v"(lo_)); const int r = lo_ & 15, q = lo_ >> 4;
            const int t0 = un * 16, t_0 = t0 + 2 * wave, t_1 = t_0 + 1;
            indexer_unit(lds, smask + wave * 64, PROJ, KIDXb, posb, b * L + t_0, t_0, ((t0 + 15) >> 6) + 1, wave, lane);
            __syncthreads();
            const bf16_t* qp0 = QB + ((size_t)(b * L + t_0) * 16 + r) * 128; const bf16_t* qp1 = QB + ((size_t)(b * L + t_1) * 16 + r) * 128;
            attn_core<128, true>(lds, Kg, Vtg, qp0, qp1, (t0 + 79) >> 6, 0, 0, 0, smask + (wave * 2 + 0) * 32, smask + (wave * 2 + 1) * 32, tb, posb, posb[t_0], posb[t_1], o, lsum);
#pragma unroll
            for (int ct = 0; ct < 2; ++ct) { const float inv = __builtin_amdgcn_rcpf(lsum[ct]); const size_t m = (size_t)b * L + (ct ? t_1 : t_0);
                const bf16_t* gp = PROJ + m * LDP + C_GB + r * 128 + 4 * q; bf16_t* op = OCAT + m * 4096 + 2048 + r * 128 + 4 * q;
#pragma unroll
                for (int dt = 0; dt < 8; ++dt) { const u32x2 g = *(const u32x2*)(gp + 16 * dt); const f32x4 v = o[ct][dt] * inv;
                    u32x2 w; w.x = pk2(v[0] * silu(lo16(g.x)), v[1] * silu(hi16(g.x))); w.y = pk2(v[2] * silu(lo16(g.y)), v[3] * silu(hi16(g.y)));
                    *(u32x2*)(op + 16 * dt) = w; } }
        }
    }
}

__global__ void __launch_bounds__(NTHREADS, 2) fwd_megakernel(Args a) {
    extern __shared__ __attribute__((aligned(16))) unsigned char lds_raw[];
    LAS unsigned char* lds = (LAS unsigned char*)lds_raw;
    const int G = gridDim.x, lo = a.ph_lo, hi = a.ph_hi;
#define IN(k) (lo <= (k) && (k) < hi)
#if MK_MULTI
#define GSYNC(k) do { } while (0)
#else
    cg::grid_group grid = cg::this_grid();
    volatile LAS unsigned* bst = (volatile LAS unsigned*)(lds + LDS_BYTES - 16);
    if (threadIdx.x < 4) bst[threadIdx.x] = 0u;
    __syncthreads();
    XcdBarrier xbar = xcd_barrier_post((unsigned*)(a.ws + WS_BAR), bst);
    if (a.ph_hi > 1000) grid.sync();
#define GSYNC(k) do { if (IN(k) && IN((k) + 1)) xcd_barrier(xbar); } while (0)
#endif
    bf16_t* PROJ = (bf16_t*)(a.ws + WS_PROJ);
    if (IN(0)) p0_prologue(a, lds, G);
    GSYNC(0);
    if (IN(1)) {
        pg8::Gemm g{(const bf16_t*)(a.ws + WS_HN), (const bf16_t*)(a.ws + WS_WIN_T), M, LDP, DM, DM, DM}; pg8::StaticOrder S; S.init(M, LDP, G, (int)blockIdx.x);
        pg8::EpiBf16 E{PROJ, LDP};
        pg8::gemm_phase<pg8::EpiBf16>(lds, g, S, E);
    }
    GSYNC(1);
    if (IN(2)) {
        { pg8::Gemm g{PROJ + C_CQ, (const bf16_t*)(a.ws + WS_WUQ_T), M, 3072, 1024, LDP, 1024}; pg8::StaticOrder S; S.init(M, 3072, G, (int)blockIdx.x);
          pg8::EpiBf16 E{(bf16_t*)(a.ws + WS_WIN_T), 3072}; pg8::gemm_phase<pg8::EpiBf16>(lds, g, S, E); }
        { pg8::Gemm g{PROJ + C_CKV, (const bf16_t*)(a.ws + WS_WUKV_T), M, 4096, 512, LDP, 512}; pg8::StaticOrder S; S.init(M, 4096, G, (int)blockIdx.x);
          pg8::EpiBf16 E{(bf16_t*)(a.ws + WS_HN), 4096}; pg8::gemm_phase<pg8::EpiBf16>(lds, g, S, E); }
    }
    GSYNC(2);
    if (IN(3)) p3_prep(a, lds, G);
    GSYNC(3);
    if (IN(4)) p4_attention<true, false>(a, lds, G);
    if (IN(5)) p4_attention<false, true>(a, lds, G);
    GSYNC(5);
    if (IN(6)) {
        pg8::Gemm g{(const bf16_t*)(a.ws + WS_HN), (const bf16_t*)(a.ws + WS_PCAT_T), M, 4096, 4096, 4096, 4096}; pg8::StaticOrder S; S.init(M, 4096, G, (int)blockIdx.x);
        pg8::EpiMerge E{(bf16_t*)(a.ws + WS_WIN_T), 4096, PROJ};
        pg8::gemm_phase<pg8::EpiMerge>(lds, g, S, E);
    }
    GSYNC(6);
    if (IN(7)) {
        pg8::Gemm g{(const bf16_t*)(a.ws + WS_WIN_T), (const bf16_t*)(a.ws + WS_WO_T), M, 4096, 4096, 4096, 4096}; pg8::StaticOrder S; S.init(M, 4096, G, (int)blockIdx.x);
        pg8::EpiResid E{a.x, a.out, 4096};
        pg8::gemm_phase<pg8::EpiResid>(lds, g, S, E);
    }
#undef IN
#undef GSYNC
}

extern "C" void kernel_launch(void* const* d_in, const int* in_sizes, int n_in, void* d_out, int out_size, void* d_ws, size_t ws_size, hipStream_t stream) {
    static int grid = 0;
    if (grid == 0) {
        if (n_in != 16 || out_size != M * DM || ws_size < WS_END) { fprintf(stderr, "kernel_launch: unexpected shapes (n_in %d, out %d, ws %zu)\n", n_in, out_size, ws_size); grid = -1; return; }
        int dev = 0, cus = 0, per_cu = 0;
        hipGetDevice(&dev); hipDeviceGetAttribute(&cus, hipDeviceAttributeMultiprocessorCount, dev);
        if (hipFuncSetAttribute((const void*)fwd_megakernel, hipFuncAttributeMaxDynamicSharedMemorySize, LDS_BYTES) != hipSuccess) { fprintf(stderr, "kernel_launch: hipFuncSetAttribute failed\n"); grid = -1; return; }
        if (hipOccupancyMaxActiveBlocksPerMultiprocessor(&per_cu, (const void*)fwd_megakernel, NTHREADS, LDS_BYTES) != hipSuccess || per_cu < 1) per_cu = 1;
        (void)hipGetLastError();
        grid = cus * per_cu;
        if (grid <= 0) grid = 256;
    }
    if (grid < 0) return;
    Args a{};
    a.x = (const float*)d_in[0]; a.pos = (const int*)d_in[1]; a.g_pre = (const float*)d_in[2]; a.w_in = (const float*)d_in[3]; a.g_q_lat = (const float*)d_in[4]; a.g_kv_lat = (const float*)d_in[5];
    a.w_uq = (const float*)d_in[6]; a.w_ukv = (const float*)d_in[7]; a.g_qn_a = (const float*)d_in[8]; a.g_kn_a = (const float*)d_in[9]; a.g_qn_b = (const float*)d_in[10]; a.g_kn_b = (const float*)d_in[11];
    a.t5 = (const float*)d_in[12]; a.p_a = (const float*)d_in[13]; a.p_b = (const float*)d_in[14]; a.w_o = (const float*)d_in[15];
    a.out = (float*)d_out; a.ws = (unsigned char*)d_ws;
#if MK_MULTI
    for (int ph = 0; ph < 8; ++ph) { a.ph_lo = ph; a.ph_hi = ph + 1; for (int rep = 0; rep < (ph == (MK_DUP) ? 2 : 1); ++rep) hipLaunchKernelGGL(fwd_megakernel, dim3(grid), dim3(NTHREADS), LDS_BYTES, stream, a); }
#else
    a.ph_lo = 0; a.ph_hi = 8;
    if (hipMemsetAsync((unsigned char*)d_ws + WS_BAR, 0, 16384, stream) != hipSuccess) { fprintf(stderr, "kernel_launch: memset of the barrier words failed\n"); return; }
    void* args[] = {&a};
    hipError_t e = hipLaunchCooperativeKernel((const void*)fwd_megakernel, dim3(grid), dim3(NTHREADS), args, LDS_BYTES, stream);
    if (e != hipSuccess) fprintf(stderr, "cooperative launch failed: %s (grid %d)\n", hipGetErrorString(e), grid);
#endif
}
```
